# Optimizing an MI355X kernel written in HIP

```python
import math
import jax
import jax.numpy as jnp
from jax import lax
import numpy as np

D_MODEL = 2048
BATCH = 4
SEQ = 4096
DEPTH = 2

D_MIX = D_MODEL
N_GROUPS = 4
GROUP_W = D_MIX // N_GROUPS
ROPE_THETA = 500000.0
NORM_EPS = 1e-6
Q_BLOCK = 128

RW_HEAD = 64
RW_HEADS = GROUP_W // RW_HEAD
RW_DECAY_LORA = 32
RW_A_LORA = 32
RW_V_LORA = 32
RW_GN_EPS = 64e-5
RW_COLS = 3 * GROUP_W + RW_DECAY_LORA + RW_A_LORA

ML_HEADS = 4
ML_HEAD = GROUP_W // ML_HEADS
ML_CONV = 4
ML_CHUNK = 64
ML_COLS = 4 * GROUP_W + 2 * ML_HEADS

MLA_HEADS = 4
MLA_V = GROUP_W // MLA_HEADS
MLA_NOPE = 128
MLA_ROPE = 64
MLA_QK = MLA_NOPE + MLA_ROPE
MLA_Q_LORA = 384
MLA_KV_LORA = 256
MLA_COLS = MLA_Q_LORA + MLA_KV_LORA + MLA_ROPE

DA_HEADS = 4
DA_V = GROUP_W // DA_HEADS
DA_QK = DA_V // 2
DA_ROT = DA_QK // 4
DA_COLS = 3 * GROUP_W

IN_WIDTHS = (D_MIX, RW_COLS, ML_COLS, MLA_COLS, DA_COLS)
N_IN = sum(IN_WIDTHS)

kernel_name = 'hybrid_rwkv7_mlstm_mla_diffattn_parallel_heads'


def _split(a, widths):
    idx = [int(i) for i in np.cumsum(widths)[:-1]]
    return jnp.split(a, idx, axis=-1)


def rms_norm(x, g, eps=NORM_EPS):
    xf = x.astype(jnp.float32)
    return xf * lax.rsqrt(jnp.mean(xf * xf, -1, keepdims=True) + eps) * g.astype(jnp.float32)


def rope_tables(T, rot_dim):
    inv = ROPE_THETA ** (-jnp.arange(0, rot_dim, 2, dtype=jnp.float32) / rot_dim)
    ang = jnp.arange(T, dtype=jnp.float32)[:, None] * inv[None, :]
    return jnp.cos(ang), jnp.sin(ang)


def apply_rope(x, cos, sin):
    half = x.shape[-1] // 2
    extra = x.ndim - 3
    c = cos.reshape((cos.shape[0],) + (1,) * extra + (half,))
    s = sin.reshape((sin.shape[0],) + (1,) * extra + (half,))
    x1, x2 = x[..., :half], x[..., half:]
    return jnp.concatenate([x1 * c - x2 * s, x2 * c + x1 * s], axis=-1)


def _token_shift(p, mu):
    prev = jnp.pad(p, ((0, 0), (1, 0), (0, 0)))[:, :-1]
    return p + (prev - p) * mu


def _causal_dwconv(x, w, b):
    K, C = w.shape
    out = lax.conv_general_dilated(x, w.astype(x.dtype)[:, None, :], window_strides=(1,),
                                   padding=[(K - 1, 0)], dimension_numbers=('NWC', 'WIO', 'NWC'),
                                   feature_group_count=C)
    return out + b.astype(x.dtype)


def causal_attention_blocks(q, k, v, coeffs, scale):
    B, T, H, M, dk = q.shape
    nb = T // Q_BLOCK
    qb = jnp.moveaxis(q.astype(jnp.float32).reshape(B, nb, Q_BLOCK, H, M, dk), 1, 0)
    kf = k.astype(jnp.float32)
    vf = v.astype(jnp.float32)
    kpos = jnp.arange(T)
    neg = jnp.finfo(jnp.float32).min

    def one_block(args):
        q_blk, start = args
        qpos = start + jnp.arange(Q_BLOCK)
        s = jnp.einsum('bqhmd,bkhmd->bhmqk', q_blk, kf) * scale
        s = jnp.where(kpos[None, :] <= qpos[:, None], s, neg)
        p = jax.nn.softmax(s, axis=-1)
        attn = jnp.einsum('m,bhmqk->bhqk', coeffs, p)
        return jnp.einsum('bhqk,bkhv->bqhv', attn, vf)

    out = lax.map(one_block, (qb, jnp.arange(nb) * Q_BLOCK))
    return jnp.moveaxis(out, 0, 1).reshape(B, T, H, v.shape[-1])


def _group_norm(y, w, b, eps):
    H, N = y.shape[-2:]
    mu = jnp.mean(y, -1, keepdims=True)
    var = jnp.mean(jnp.square(y - mu), -1, keepdims=True)
    return (y - mu) * lax.rsqrt(var + eps) * w.reshape(H, N) + b.reshape(H, N)


def _wkv7_scan(r, w, k, v, kk, a):
    B, T, H, N = r.shape

    def step(S, inp):
        r_t, w_t, k_t, v_t, kk_t, a_t = inp
        sa = jnp.einsum('bhvk,bhk->bhv', S, -kk_t)
        S = S * w_t[:, :, None, :] + sa[..., None] * (kk_t * a_t)[:, :, None, :] + v_t[..., None] * k_t[:, :, None, :]
        return S, jnp.einsum('bhvk,bhk->bhv', S, r_t)

    xs = tuple(jnp.moveaxis(t, 1, 0) for t in (r, w, k, v, kk, a))
    _, y = lax.scan(step, jnp.zeros((B, H, N, N), jnp.float32), xs)
    return jnp.moveaxis(y, 0, 1)


def rwkv7_group(p, v_first, mu, w0, w_up, a0, a_up, v_res, k_k, k_a, r_k, ln_w, ln_b):
    B, T, _ = p.shape
    p = _token_shift(p.astype(jnp.float32), mu)
    r, k, v, wd, ad = _split(p, (GROUP_W, GROUP_W, GROUP_W, RW_DECAY_LORA, RW_A_LORA))
    decay = jnp.exp(-jnp.exp(-jax.nn.softplus(-(w0 + jnp.tanh(wd) @ w_up)) - 0.5))
    a = jax.nn.sigmoid(a0 + ad @ a_up)
    if v_res is None:
        v_first = v
    else:
        v0, v_dn, v_up = v_res
        v = v + (v_first - v) * jax.nn.sigmoid(v0 + (v @ v_dn) @ v_up)

    def hd(t):
        return t.reshape(B, T, RW_HEADS, RW_HEAD)

    kk = hd(k * k_k)
    kk = kk / jnp.maximum(jnp.sqrt(jnp.sum(kk * kk, -1, keepdims=True)), 1e-12)
    k = k * (1.0 + (a - 1.0) * k_a)
    r, k, v, decay, a = hd(r), hd(k), hd(v), hd(decay), hd(a)
    y = _wkv7_scan(r, decay, k, v, kk, a)
    y = _group_norm(y, ln_w, ln_b, RW_GN_EPS) + jnp.sum(r * k * r_k, -1, keepdims=True) * v
    return y.reshape(B, T, GROUP_W), v_first


def _mlstm_chunkwise(q, k, v, i_pre, log_f):
    B, H, T, dk = q.shape
    dv = v.shape[-1]
    L = ML_CHUNK
    NC = T // L
    q = q.reshape(B, H, NC, L, dk)
    k = k.reshape(B, H, NC, L, dk)
    v = v.reshape(B, H, NC, L, dv)
    ig = i_pre.reshape(B, H, NC, L)
    b = jnp.cumsum(log_f.reshape(B, H, NC, L), axis=-1)
    b_last = b[..., -1]
    g = b_last[..., None] - b + ig
    g_max = jnp.max(g, axis=-1)
    wgt = jnp.exp(g - g_max[..., None])
    C_chunk = jnp.einsum('bhcs,bhcsv,bhcsk->bhcvk', wgt, v, k)
    n_chunk = jnp.einsum('bhcs,bhcsk->bhck', wgt, k)

    def step(carry, inp):
        C, n, m = carry
        bl, gm, Cc, nc = inp
        m_new = jnp.maximum(bl + m, gm)
        a_old = jnp.exp(bl + m - m_new)
        a_new = jnp.exp(gm - m_new)
        C_new = a_old[..., None, None] * C + a_new[..., None, None] * Cc
        n_new = a_old[..., None] * n + a_new[..., None] * nc
        return (C_new, n_new, m_new), (C, n, m)

    init = (jnp.zeros((B, H, dv, dk), jnp.float32), jnp.zeros((B, H, dk), jnp.float32),
            jnp.zeros((B, H), jnp.float32))
    xs = (jnp.moveaxis(b_last, 2, 0), jnp.moveaxis(g_max, 2, 0),
          jnp.moveaxis(C_chunk, 2, 0), jnp.moveaxis(n_chunk, 2, 0))
    _, (C_prev, n_prev, m_prev) = lax.scan(step, init, xs)
    C_prev = jnp.moveaxis(C_prev, 0, 2)
    n_prev = jnp.moveaxis(n_prev, 0, 2)
    m_prev = jnp.moveaxis(m_prev, 0, 2)

    mask = jnp.tril(jnp.ones((L, L), dtype=bool))
    D = b[..., :, None] - b[..., None, :] + ig[..., None, :]
    D = jnp.where(mask, D, -jnp.inf)
    inter_log = b + m_prev[..., None]
    m_j = jnp.maximum(inter_log, jnp.max(D, axis=-1))
    s = jnp.einsum('bhcjd,bhcsd->bhcjs', q, k) * jnp.exp(D - m_j[..., None])
    inter_w = jnp.exp(inter_log - m_j)
    num = jnp.einsum('bhcjs,bhcsv->bhcjv', s, v) + inter_w[..., None] * jnp.einsum('bhcvk,bhcjk->bhcjv', C_prev, q)
    den = jnp.sum(s, axis=-1) + inter_w * jnp.einsum('bhck,bhcjk->bhcj', n_prev, q)
    h = num / jnp.maximum(jnp.abs(den), jnp.exp(-m_j))[..., None]
    return h.reshape(B, H, T, dv)


def mlstm_group(p, conv_w, conv_b, i_b, f_b, norm_g):
    B, T, _ = p.shape
    qk, v, o, ig, fg = _split(p.astype(jnp.float32), (2 * GROUP_W, GROUP_W, GROUP_W, ML_HEADS, ML_HEADS))
    qk = jax.nn.silu(_causal_dwconv(qk, conv_w, conv_b))
    q, k = _split(qk, (GROUP_W, GROUP_W))

    def hd(t):
        return t.reshape(B, T, ML_HEADS, ML_HEAD).transpose(0, 2, 1, 3)

    i_pre = jnp.transpose(ig + i_b, (0, 2, 1))
    log_f = jnp.transpose(jax.nn.log_sigmoid(fg + f_b), (0, 2, 1))
    h = _mlstm_chunkwise(hd(q), hd(k) * ML_HEAD ** -0.5, hd(v), i_pre, log_f)
    h = rms_norm(h.transpose(0, 2, 1, 3), norm_g.reshape(ML_HEADS, ML_HEAD))
    h = jax.nn.sigmoid(o).reshape(B, T, ML_HEADS, ML_HEAD) * h
    return h.reshape(B, T, GROUP_W)


def mla_group(p, cos, sin, q_norm_g, kv_norm_g, w_q_b, w_kv_b, q_g, k_g):
    B, T, _ = p.shape
    q_lat, kv_lat, k_pe = _split(p.astype(jnp.float32), (MLA_Q_LORA, MLA_KV_LORA, MLA_ROPE))
    q = (rms_norm(q_lat, q_norm_g) @ w_q_b).reshape(B, T, MLA_HEADS, MLA_QK)
    kv = (rms_norm(kv_lat, kv_norm_g) @ w_kv_b).reshape(B, T, MLA_HEADS, MLA_NOPE + MLA_V)
    k_nope, v = kv[..., :MLA_NOPE], kv[..., MLA_NOPE:]
    k = jnp.concatenate([k_nope, jnp.broadcast_to(k_pe[:, :, None, :], (B, T, MLA_HEADS, MLA_ROPE))], -1)
    q = rms_norm(q, q_g)
    k = rms_norm(k, k_g)
    q = jnp.concatenate([q[..., :MLA_NOPE], apply_rope(q[..., MLA_NOPE:], cos, sin)], -1)
    k = jnp.concatenate([k[..., :MLA_NOPE], apply_rope(k[..., MLA_NOPE:], cos, sin)], -1)
    o = causal_attention_blocks(q[:, :, :, None, :], k[:, :, :, None, :], v,
                                jnp.ones((1,), jnp.float32), MLA_QK ** -0.5)
    return o.reshape(B, T, GROUP_W)


def diff_attn_group(p, layer, cos, sin, q_g, k_g, lq1, lk1, lq2, lk2, sub_g):
    B, T, _ = p.shape
    q, k, v = _split(p.astype(jnp.float32), (GROUP_W, GROUP_W, GROUP_W))
    q = rms_norm(q.reshape(B, T, DA_HEADS, 2, DA_QK), q_g)
    k = rms_norm(k.reshape(B, T, DA_HEADS, 2, DA_QK), k_g)
    q = jnp.concatenate([apply_rope(q[..., :DA_ROT], cos, sin), q[..., DA_ROT:]], -1)
    k = jnp.concatenate([apply_rope(k[..., :DA_ROT], cos, sin), k[..., DA_ROT:]], -1)
    v = v.reshape(B, T, DA_HEADS, DA_V)
    lam_init = 0.8 - 0.6 * math.exp(-0.3 * layer)
    lam = (jnp.exp(jnp.sum(lq1.astype(jnp.float32) * lk1.astype(jnp.float32)))
           - jnp.exp(jnp.sum(lq2.astype(jnp.float32) * lk2.astype(jnp.float32))) + lam_init)
    coeffs = jnp.stack([jnp.ones((), jnp.float32), -lam])
    o = causal_attention_blocks(q, k, v, coeffs, DA_QK ** -0.5)
    o = rms_norm(o, sub_g) * (1.0 - lam_init)
    return o.reshape(B, T, GROUP_W)


def setup_inputs(seed: int = 0) -> dict:
    key = jax.random.key(seed)
    ks = iter(jax.random.split(key, 48))
    f32 = jnp.float32
    L = DEPTH
    G = GROUP_W

    def nrm(shape, scale):
        return scale * jax.random.normal(next(ks), shape, f32)

    def gain(shape):
        return 1.0 + nrm(shape, 0.02)

    return {
        'x': jax.random.normal(next(ks), (BATCH, SEQ, D_MODEL), f32),
        'norm_g': gain((L, D_MODEL)),
        'w_in': nrm((L, D_MODEL, N_IN), D_MODEL ** -0.5),
        'w_out': nrm((L, D_MIX, D_MODEL), D_MIX ** -0.5),
        'branch_beta': gain((L, N_GROUPS)),
        'rw_mu': jax.random.uniform(next(ks), (L, RW_COLS), f32),
        'rw_w0': jax.random.uniform(next(ks), (L, G), f32, -6.0, 1.0),
        'rw_w_up': nrm((L, RW_DECAY_LORA, G), 0.1 * RW_DECAY_LORA ** -0.5),
        'rw_a0': nrm((L, G), 0.1),
        'rw_a_up': nrm((L, RW_A_LORA, G), 0.1 * RW_A_LORA ** -0.5),
        'rw_v0': 1.0 + nrm((L - 1, G), 0.1),
        'rw_v_dn': nrm((L - 1, G, RW_V_LORA), G ** -0.5),
        'rw_v_up': nrm((L - 1, RW_V_LORA, G), 0.1 * RW_V_LORA ** -0.5),
        'rw_k_k': 0.85 + nrm((L, G), 0.05),
        'rw_k_a': 1.0 + nrm((L, G), 0.05),
        'rw_r_k': nrm((L, RW_HEADS, RW_HEAD), 0.1),
        'rw_ln_w': gain((L, G)),
        'rw_ln_b': nrm((L, G), 0.02),
        'ml_conv_w': nrm((L, ML_CONV, 2 * G), ML_CONV ** -0.5),
        'ml_conv_b': nrm((L, 2 * G), 0.02),
        'ml_i_b': nrm((L, ML_HEADS), 0.1),
        'ml_f_b': jax.random.uniform(next(ks), (L, ML_HEADS), f32, 3.0, 6.0),
        'ml_norm_g': gain((L, G)),
        'mla_q_norm_g': gain((L, MLA_Q_LORA)),
        'mla_kv_norm_g': gain((L, MLA_KV_LORA)),
        'mla_w_q_b': nrm((L, MLA_Q_LORA, MLA_HEADS * MLA_QK), MLA_Q_LORA ** -0.5),
        'mla_w_kv_b': nrm((L, MLA_KV_LORA, MLA_HEADS * (MLA_NOPE + MLA_V)), MLA_KV_LORA ** -0.5),
        'mla_q_g': gain((L, MLA_QK)),
        'mla_k_g': gain((L, MLA_QK)),
        'da_q_g': gain((L, DA_QK)),
        'da_k_g': gain((L, DA_QK)),
        'da_lq1': nrm((L, DA_QK), 0.1),
        'da_lk1': nrm((L, DA_QK), 0.1),
        'da_lq2': nrm((L, DA_QK), 0.1),
        'da_lk2': nrm((L, DA_QK), 0.1),
        'da_sub_g': gain((L, DA_V)),
    }


def reference(x, norm_g, w_in, w_out, branch_beta, rw_mu, rw_w0, rw_w_up, rw_a0, rw_a_up,
              rw_v0, rw_v_dn, rw_v_up, rw_k_k, rw_k_a, rw_r_k, rw_ln_w, rw_ln_b,
              ml_conv_w, ml_conv_b, ml_i_b, ml_f_b, ml_norm_g,
              mla_q_norm_g, mla_kv_norm_g, mla_w_q_b, mla_w_kv_b, mla_q_g, mla_k_g,
              da_q_g, da_k_g, da_lq1, da_lk1, da_lq2, da_lk2, da_sub_g):
    T = x.shape[1]
    cos_mla, sin_mla = rope_tables(T, MLA_ROPE)
    cos_da, sin_da = rope_tables(T, DA_ROT)
    v_first = None
    for l in range(DEPTH):
        h = rms_norm(x, norm_g[l]).astype(x.dtype)
        p = h @ w_in[l]
        z, p_rw, p_ml, p_mla, p_da = _split(p, IN_WIDTHS)
        v_res = None if l == 0 else (rw_v0[l - 1], rw_v_dn[l - 1], rw_v_up[l - 1])
        y_rw, v_first = rwkv7_group(p_rw, v_first, rw_mu[l], rw_w0[l], rw_w_up[l], rw_a0[l], rw_a_up[l],
                                    v_res, rw_k_k[l], rw_k_a[l], rw_r_k[l], rw_ln_w[l], rw_ln_b[l])
        y_ml = mlstm_group(p_ml, ml_conv_w[l], ml_conv_b[l], ml_i_b[l], ml_f_b[l], ml_norm_g[l])
        y_mla = mla_group(p_mla, cos_mla, sin_mla, mla_q_norm_g[l], mla_kv_norm_g[l],
                          mla_w_q_b[l], mla_w_kv_b[l], mla_q_g[l], mla_k_g[l])
        y_da = diff_attn_group(p_da, l, cos_da, sin_da, da_q_g[l], da_k_g[l],
                               da_lq1[l], da_lk1[l], da_lq2[l], da_lk2[l], da_sub_g[l])
        beta = branch_beta[l].astype(jnp.float32)
        y = jnp.concatenate([beta[0] * y_rw, beta[1] * y_ml, beta[2] * y_mla, beta[3] * y_da], axis=-1)
        y = y * jax.nn.silu(z.astype(jnp.float32))
        x = x + (y.astype(x.dtype) @ w_out[l]).astype(x.dtype)
    return x
```

```cpp
#include <hip/hip_runtime.h>
#include <hip/hip_cooperative_groups.h>
#include <cstdio>
#include <cstdint>
namespace cg = cooperative_groups;

typedef unsigned short bf16_t;
typedef short bf16x8 __attribute__((ext_vector_type(8)));
typedef float f32x4 __attribute__((ext_vector_type(4)));
typedef float f32x16 __attribute__((ext_vector_type(16)));
typedef unsigned u32x4 __attribute__((ext_vector_type(4)));
typedef unsigned u32x2 __attribute__((ext_vector_type(2)));
#define LAS __attribute__((address_space(3)))

constexpr int NTOK = 16384, DM = 2048, TT = 4096, NBATCH = 4, NP = 7936, NIN = 7944;
constexpr int C_Z = 0, C_RWR = 2048, C_RWK = 2560, C_RWV = 3072, C_RWWD = 3584;
constexpr int C_MLQ = 3648, C_MLK = 4160, C_MLV = 4672, C_MLO = 5184;
constexpr int C_QLAT = 5696, C_KVLAT = 6080, C_KPE = 6336;
constexpr int C_DAQ = 6400, C_DAK = 6912, C_DAV = 7424;
constexpr int Y_RW = 0, Y_ML = 512, Y_MLA = 1024, Y_DA = 1536;
constexpr int GATE_COL = 5696;

constexpr size_t MiB = 1u << 20;
constexpr size_t WS_CTL = 0;
__host__ __device__ constexpr size_t WS_WIN(int l) { return (1 + 31 * (size_t)l) * MiB; }
__host__ __device__ constexpr size_t WS_WOUT(int l) { return (63 + 8 * (size_t)l) * MiB; }
__host__ __device__ constexpr size_t WS_WQ(int l) { return 79 * MiB + (size_t)l * 655360; }
__host__ __device__ constexpr size_t WS_WKV(int l) { return 79 * MiB + 2 * 655360 + (size_t)l * 524288; }
__host__ __device__ constexpr size_t WS_WG(int l) { return 79 * MiB + 2 * 655360 + 2 * 524288 + (size_t)l * 65536; }
constexpr size_t WS_ROPE = 81 * MiB + 524288;
constexpr size_t WS_RSTD = 83 * MiB;
constexpr size_t WS_VDNT = 83 * MiB + 131072;
constexpr size_t WS_GATES = 83 * MiB + 524288;
constexpr size_t WS_VL = 84 * MiB;
constexpr size_t WS_XB = 86 * MiB;
constexpr size_t WS_P = 150 * MiB;
constexpr size_t WS_QRAW = 398 * MiB;
constexpr size_t WS_KVRAW = 422 * MiB;
constexpr size_t WS_KMLA = 454 * MiB;
constexpr size_t WS_VFIRST = 478 * MiB;
constexpr size_t WS_BV = 494 * MiB;
constexpr size_t WS_END = 510 * MiB;

struct Params { const float* in[36]; float* out; unsigned char* ws; };

__device__ __forceinline__ float bf2f(bf16_t v) { return __uint_as_float((unsigned)v << 16); }
__device__ __forceinline__ unsigned f2bf(float f) { unsigned u = __float_as_uint(f); return (u + 0x7fffu + ((u >> 16) & 1u)) >> 16; }
__device__ __forceinline__ unsigned pk2(float lo, float hi) { return f2bf(lo) | (f2bf(hi) << 16); }
__device__ __forceinline__ float dpp_sel(float v, const int sel) {
    const int x = __builtin_bit_cast(int, v); int r;
    if (sel == 0) r = __builtin_amdgcn_update_dpp(0, x, 0xB1, 0xF, 0xF, true);
    else if (sel == 1) r = __builtin_amdgcn_update_dpp(0, x, 0x4E, 0xF, 0xF, true);
    else if (sel == 2) r = __builtin_amdgcn_update_dpp(0, x, 0x141, 0xF, 0xF, true);
    else r = __builtin_amdgcn_update_dpp(0, x, 0x140, 0xF, 0xF, true);
    return __builtin_bit_cast(float, r);
}
__device__ __forceinline__ float wave_sum(float v) {
    v += dpp_sel(v, 0); v += dpp_sel(v, 1); v += dpp_sel(v, 2); v += dpp_sel(v, 3);
    const int x = __builtin_bit_cast(int, v);
    const float s0 = __builtin_bit_cast(float, __builtin_amdgcn_readlane(x, 0)), s1 = __builtin_bit_cast(float, __builtin_amdgcn_readlane(x, 16));
    const float s2 = __builtin_bit_cast(float, __builtin_amdgcn_readlane(x, 32)), s3 = __builtin_bit_cast(float, __builtin_amdgcn_readlane(x, 48));
    return (s0 + s1) + (s2 + s3);
}
__device__ __forceinline__ float xor32_get(float v) { int l_; asm volatile("v_mbcnt_lo_u32_b32 %0, -1, 0\n\tv_mbcnt_hi_u32_b32 %0, -1, %0" : "=v"(l_));
    return __builtin_bit_cast(float, __builtin_amdgcn_ds_bpermute((l_ ^ 32) << 2, __builtin_bit_cast(int, v))); }
__device__ __forceinline__ float xor32_sum(float v) { return v + xor32_get(v); }
__device__ __forceinline__ float xor32_max(float v) { return fmaxf(v, xor32_get(v)); }
__device__ __forceinline__ float xor32_max_fast(float v) { float a = v, b; asm volatile("s_nop 1\n\tv_mov_b32 %1, %0\n\ts_nop 1\n\tv_permlane32_swap_b32 %0, %1\n\ts_nop 1" : "+v"(a), "=&v"(b)); return fmaxf(a, b); }
__device__ __forceinline__ float scan_sum64(float v) {
#define SC_STEP(ctrl, rm) v += __builtin_bit_cast(float, __builtin_amdgcn_update_dpp(0, __builtin_bit_cast(int, v), ctrl, rm, 0xF, false))
    SC_STEP(0x111, 0xF); SC_STEP(0x112, 0xF); SC_STEP(0x114, 0xF); SC_STEP(0x118, 0xF); SC_STEP(0x142, 0xA); SC_STEP(0x143, 0xC);
#undef SC_STEP
    return v;
}
__device__ __forceinline__ float scan_max64(float v) {
    const int ninf = (int)0xff800000u;
#define SC_STEP(ctrl, rm) v = fmaxf(v, __builtin_bit_cast(float, __builtin_amdgcn_update_dpp(ninf, __builtin_bit_cast(int, v), ctrl, rm, 0xF, false)))
    SC_STEP(0x111, 0xF); SC_STEP(0x112, 0xF); SC_STEP(0x114, 0xF); SC_STEP(0x118, 0xF); SC_STEP(0x142, 0xA); SC_STEP(0x143, 0xC);
#undef SC_STEP
    return v;
}
__device__ __forceinline__ float lane63(float v) { return __builtin_bit_cast(float, __builtin_amdgcn_readlane(__builtin_bit_cast(int, v), 63)); }
__device__ __forceinline__ float softplusf_(float x) { return x > 20.f ? x : log1pf(expf(x)); }
#define LDS_WAIT() asm volatile("s_waitcnt lgkmcnt(0)" ::: "memory")
#define LDS_BARRIER() do { asm volatile("s_waitcnt lgkmcnt(0)" ::: "memory"); __builtin_amdgcn_s_barrier(); asm volatile("" ::: "memory"); } while (0)
__device__ __forceinline__ int lane_id_opaque() { int l; asm volatile("v_mbcnt_lo_u32_b32 %0, -1, 0\n\tv_mbcnt_hi_u32_b32 %0, -1, %0" : "=v"(l)); return l; }
#define PHASE_TID(wid) ((wid) * 64 + lane_id_opaque())
#define OPAQUE_S(x) asm volatile("" : "+s"(x))

__device__ __forceinline__ void sincos_d(double x, double& s, double& c) {
    const double k = rint(x * 0.6366197723675814);
    double r = fma(-k, 1.5707963267948966, x); r = fma(-k, 6.123233995736766e-17, r);
    const int q = (int)((long long)k) & 3;
    const double r2 = r * r;
    const double sp = r * (1.0 + r2 * (-1.0 / 6 + r2 * (1.0 / 120 + r2 * (-1.0 / 5040 + r2 * (1.0 / 362880 + r2 * (-1.0 / 39916800 + r2 * (1.0 / 6227020800.0)))))));
    const double cp = 1.0 + r2 * (-0.5 + r2 * (1.0 / 24 + r2 * (-1.0 / 720 + r2 * (1.0 / 40320 + r2 * (-1.0 / 3628800 + r2 * (1.0 / 479001600.0 + r2 * (-1.0 / 87178291200.0)))))));
    if (q == 0) { s = sp; c = cp; } else if (q == 1) { s = cp; c = -sp; } else if (q == 2) { s = -sp; c = -cp; } else { s = -cp; c = sp; }
}
__device__ __forceinline__ float inv_mla(int i) {
    const float t[32] = {1.000000000e+00f, 6.636012793e-01f, 4.403665960e-01f, 2.922278047e-01f, 1.939227432e-01f, 1.286873668e-01f, 8.539710194e-02f, 5.666962266e-02f, 3.760603070e-02f, 2.495540865e-02f, 1.656043902e-02f, 1.098952908e-02f, 7.292664610e-03f, 4.839421250e-03f, 3.211445874e-03f, 2.131119603e-03f, 1.414213562e-03f, 9.384738514e-04f, 6.227723788e-04f, 4.132725589e-04f, 2.742481884e-04f, 1.819914323e-04f, 1.207697351e-04f, 8.014294872e-05f, 5.318296098e-05f, 3.529227615e-05f, 2.341999971e-05f, 1.554154005e-05f, 1.031338616e-05f, 6.843975370e-06f, 4.541670478e-06f, 3.013858077e-06f};
    float r = t[0];
#pragma unroll
    for (int j = 1; j < 32; ++j) r = (i == j) ? t[j] : r;
    return r;
}
__device__ __forceinline__ float inv_da(int i) {
    const float t[8] = {1.000000000e+00f, 1.939227432e-01f, 3.760603070e-02f, 7.292664610e-03f, 1.414213562e-03f, 2.742481884e-04f, 5.318296098e-05f, 1.031338616e-05f};
    float r = t[0];
#pragma unroll
    for (int j = 1; j < 8; ++j) r = (i == j) ? t[j] : r;
    return r;
}

namespace pg8 {
constexpr int BM = 256, BK = 64, HALF = 128, HTB = HALF * BK * 2, STAGE_BYTES = 8 * HTB, NXCD = 8, WGM = 8;
__host__ __device__ __forceinline__ int lds_byte(int r, int c) { const int st = (r >> 4) * 2 + (c >> 5), rr = r & 15, cc = c & 31, ob = rr * 64 + cc * 2; return st * 1024 + (ob ^ (((ob >> 9) & 1) << 5)); }
__host__ __device__ __forceinline__ void stage_rc(int b, int& R, int& C) { const int st = b / 1024, sb = b % 1024, swz = sb ^ (((sb >> 9) & 1) << 5); R = (st >> 1) * 16 + swz / 64; C = (st & 1) * 32 + (swz % 64) / 2; }
__host__ __device__ __forceinline__ int perm32(int rho) { const int n = rho >> 4, i = rho & 15; return 8 * (i >> 2) + 4 * n + (i & 3); }
struct Unit { int pm, pn; };
struct Gemm { const bf16_t* A; const bf16_t* Bt; int M, N, K, lda; };
struct StaticOrder {
    int nM, nN, nwg, G, c;
    __host__ __device__ void init(int M, int N, int G_, int c_) { nM = M / BM; nN = N / BM; nwg = nM * nN; G = G_; c = c_; }
    __host__ __device__ bool next(int i, Unit& u) const {
        const long L = (long)i * G + c; if (L >= nwg) return false;
        int wgid = (int)L; { const int q = nwg / NXCD, r = nwg % NXCD, xcd = wgid % NXCD, off = wgid / NXCD; wgid = (xcd < r ? xcd * (q + 1) : r * (q + 1) + (xcd - r) * q) + off; }
        const int nig = WGM * nN, gid = wgid / nig, fm = gid * WGM, gsz = (nM - fm) < WGM ? (nM - fm) : WGM;
        u.pm = fm + ((wgid % nig) % gsz); u.pn = (wgid % nig) / gsz; return true;
    }
};
__device__ __forceinline__ unsigned cvt_pk_bf16(float lo, float hi) { unsigned r; asm volatile("v_cvt_pk_bf16_f32 %0, %1, %2" : "=v"(r) : "v"(lo), "v"(hi)); return r; }

struct EpiRowScaleBf16 {
    static constexpr bool PERM = true;
    bf16_t* O; const float* rs; int ldc; int pad;
    __device__ __forceinline__ void operator()(const f32x4 (&acc)[2][2][4][2], const Unit& u, int wr, int wc, int fr, int fq) const {
        const int row0 = u.pm * BM + wr * 64 + fr, col0 = u.pn * BM + wc * 32 + 8 * fq;
#pragma unroll
        for (int ai = 0; ai < 2; ++ai)
#pragma unroll
            for (int m = 0; m < 4; ++m) {
                const int row = row0 + ai * HALF + m * 16; const float sc = rs ? rs[row] : 1.f; bf16_t* rowp = O + (size_t)row * ldc + col0;
#pragma unroll
                for (int bj = 0; bj < 2; ++bj) { f32x4 v0 = acc[ai][bj][m][0] * sc, v1 = acc[ai][bj][m][1] * sc;
                    u32x4 w; w.x = cvt_pk_bf16(v0[0], v0[1]); w.y = cvt_pk_bf16(v0[2], v0[3]); w.z = cvt_pk_bf16(v1[0], v1[1]); w.w = cvt_pk_bf16(v1[2], v1[3]);
                    *(u32x4*)(rowp + bj * HALF) = w; } }
    }
};
struct EpiResidual {
    static constexpr bool PERM = false;
    const float* base; float* out; int ldc; int pad;
    __device__ __forceinline__ void operator()(const f32x4 (&acc)[2][2][4][2], const Unit& u, int wr, int wc, int fr, int fq) const {
        const int col0 = u.pn * BM + wc * 32 + 4 * fq;
#pragma unroll
        for (int ai = 0; ai < 2; ++ai)
#pragma unroll
            for (int m = 0; m < 4; ++m) { const size_t off = (size_t)(u.pm * BM + ai * HALF + wr * 64 + m * 16 + fr) * ldc + col0;
#pragma unroll
                for (int bj = 0; bj < 2; ++bj)
#pragma unroll
                    for (int n = 0; n < 2; ++n) { const f32x4 bs = *(const f32x4*)(base + off + bj * HALF + n * 16); *(f32x4*)(out + off + bj * HALF + n * 16) = bs + acc[ai][bj][m][n]; } }
    }
};

template <class Epi, class Sched, bool ALIGN_EPI>
__device__ __forceinline__ void gemm_phase(LAS unsigned char* lds, const Gemm g, const Sched& S, const Epi& E, const int wid) {
    const int tid = PHASE_TID(wid);
    const int lane = tid & 63, wr = wid >> 2, wc = wid & 3, fr = lane & 15, fq = lane >> 4;
    const int K = g.K, nt = K / BK, lda = g.lda;
    unsigned voffA[2], voffB[2];
#pragma unroll
    for (int i = 0; i < 2; ++i) { int R, C; stage_rc(tid * 16 + i * 8192, R, C); const int Rb = Epi::PERM ? ((R & ~31) + perm32(R & 31)) : R;
        voffA[i] = (unsigned)(R * lda + C) * 2u; voffB[i] = (unsigned)(Rb * K + C) * 2u; }
    const size_t kstep = (size_t)(BK * 2);
    const size_t hstepA = (size_t)HALF * lda * 2, hstepB = (size_t)HALF * K * 2;
    const size_t tstepA = 2 * hstepA, tstepB = 2 * hstepB;
    const unsigned ldsw = (unsigned)wid * 1024u;
    const int aoff = lds_byte(wr * 64 + fr, fq * 8), boff = lds_byte(wc * 32 + fr, fq * 8);
#define PG8_SA(b, h) (((b) * 2 + (h)) * HTB)
#define PG8_SB(b, h) ((4 + (b) * 2 + (h)) * HTB)
#define PG8_STAGE(bufoff, gbase, voff) do { _Pragma("unroll") for (int _i = 0; _i < 2; ++_i) \
        __builtin_amdgcn_global_load_lds((const unsigned*)((const char*)(gbase) + (voff)[_i]), (LAS unsigned*)(lds + (bufoff) + ldsw + _i * 8192), 16, 0, 0); } while (0)
#define PG8_LDA(dst, b, h) do { _Pragma("unroll") for (int m = 0; m < 4; ++m) _Pragma("unroll") for (int k = 0; k < 2; ++k) dst[m][k] = *(const LAS bf16x8*)(lds + PG8_SA(b, h) + aoff + m * 2048 + k * 1024); } while (0)
#define PG8_LDB(dst, b, h) do { _Pragma("unroll") for (int n = 0; n < 2; ++n) _Pragma("unroll") for (int k = 0; k < 2; ++k) dst[n][k] = *(const LAS bf16x8*)(lds + PG8_SB(b, h) + boff + n * 2048 + k * 1024); } while (0)
#define PG8_MMA(ai, bj, At, Bt) do { __builtin_amdgcn_s_setprio(1); _Pragma("unroll") for (int m = 0; m < 4; ++m) _Pragma("unroll") for (int n = 0; n < 2; ++n) _Pragma("unroll") for (int k = 0; k < 2; ++k) \
        acc[ai][bj][m][n] = __builtin_amdgcn_mfma_f32_16x16x32_bf16(Bt[n][k], At[m][k], acc[ai][bj][m][n], 0, 0, 0); __builtin_amdgcn_s_setprio(0); } while (0)
#define PG8_WAIT_V(n) asm volatile("s_waitcnt vmcnt(" #n ")" ::: "memory")
#define PG8_WAIT_L(n) asm volatile("s_waitcnt lgkmcnt(" #n ")" ::: "memory")
#define PG8_BAR __builtin_amdgcn_s_barrier()
#define PG8_SCHED __builtin_amdgcn_sched_barrier(0)
    Unit cur, nxt; int ui = 0;
    if (!S.next(0, cur)) return;
    f32x4 acc[2][2][4][2];
#pragma unroll
    for (int a = 0; a < 2; ++a)
#pragma unroll
        for (int b = 0; b < 2; ++b)
#pragma unroll
            for (int m = 0; m < 4; ++m)
#pragma unroll
                for (int n = 0; n < 2; ++n) acc[a][b][m][n] = (f32x4){0.f, 0.f, 0.f, 0.f};
    bf16x8 At[4][2], B0[2][2], B1[2][2];
    const char* cA = (const char*)g.A + (size_t)cur.pm * tstepA; const char* cB = (const char*)g.Bt + (size_t)cur.pn * tstepB;
    PG8_STAGE(PG8_SB(0, 0), cB, voffB); PG8_STAGE(PG8_SB(0, 1), cB + hstepB, voffB); PG8_STAGE(PG8_SA(0, 0), cA, voffA); PG8_STAGE(PG8_SA(0, 1), cA + hstepA, voffA);
    if (wr == 1) PG8_BAR;
    PG8_WAIT_V(2); PG8_BAR;
    PG8_STAGE(PG8_SB(1, 0), cB + kstep, voffB); PG8_STAGE(PG8_SA(1, 0), cA + kstep, voffA); PG8_STAGE(PG8_SB(1, 1), cB + hstepB + kstep, voffB);
    PG8_WAIT_V(6); PG8_BAR;
    for (;;) {
        const bool has_next = S.next(ui + 1, nxt);
        const char* nA = has_next ? (const char*)g.A + (size_t)nxt.pm * tstepA : cA; const char* nB = has_next ? (const char*)g.Bt + (size_t)nxt.pn * tstepB : cB;
        for (int t = 0; t < nt; t += 2) {
            const bool last = (t == nt - 2);
            const char* a1 = cA + (size_t)(t + 1) * kstep;
            const char* a2 = last ? nA : cA + (size_t)(t + 2) * kstep; const char* b2 = last ? nB : cB + (size_t)(t + 2) * kstep;
            const char* a3 = a2 + kstep; const char* b3 = b2 + kstep;
            PG8_LDB(B0, 0, 0); PG8_LDB(B1, 0, 1); PG8_SCHED; PG8_LDA(At, 0, 0); PG8_STAGE(PG8_SA(1, 1), a1 + hstepA, voffA);
            PG8_WAIT_V(8); PG8_WAIT_L(0); PG8_BAR; PG8_MMA(0, 0, At, B0); PG8_MMA(0, 1, At, B1); PG8_BAR; PG8_SCHED;
            PG8_LDA(At, 0, 1); PG8_STAGE(PG8_SB(0, 0), b2, voffB); PG8_STAGE(PG8_SB(0, 1), b2 + hstepB, voffB); PG8_STAGE(PG8_SA(0, 0), a2, voffA);
            PG8_WAIT_V(8); PG8_WAIT_L(0); PG8_BAR; PG8_MMA(1, 0, At, B0); PG8_MMA(1, 1, At, B1); PG8_BAR; PG8_SCHED;
            PG8_LDB(B0, 1, 0); PG8_LDB(B1, 1, 1); PG8_SCHED; PG8_LDA(At, 1, 0); PG8_STAGE(PG8_SA(0, 1), a2 + hstepA, voffA);
            PG8_WAIT_V(8); PG8_WAIT_L(0); PG8_BAR; PG8_MMA(0, 0, At, B0); PG8_MMA(0, 1, At, B1); PG8_BAR; PG8_SCHED;
            PG8_LDA(At, 1, 1); PG8_STAGE(PG8_SB(1, 0), b3, voffB); PG8_STAGE(PG8_SB(1, 1), b3 + hstepB, voffB); PG8_STAGE(PG8_SA(1, 0), a3, voffA);
            PG8_WAIT_V(8); PG8_WAIT_L(0); PG8_BAR; PG8_MMA(1, 0, At, B0); PG8_MMA(1, 1, At, B1); PG8_BAR; PG8_SCHED;
        }
        if constexpr (ALIGN_EPI) { if (wr == 0) PG8_BAR; }
        E(acc, cur, wr, wc, fr, fq);
        if (!has_next) break;
#pragma unroll
        for (int a = 0; a < 2; ++a)
#pragma unroll
            for (int b = 0; b < 2; ++b)
#pragma unroll
                for (int m = 0; m < 4; ++m)
#pragma unroll
                    for (int n = 0; n < 2; ++n) acc[a][b][m][n] = (f32x4){0.f, 0.f, 0.f, 0.f};
        cur = nxt; cA = nA; cB = nB; ++ui;
        if constexpr (ALIGN_EPI) { if (wr == 1) PG8_BAR; }
    }
    PG8_WAIT_V(0);
    if constexpr (!ALIGN_EPI) { if (wr == 0) PG8_BAR; }
    PG8_BAR;
#undef PG8_SA
#undef PG8_SB
#undef PG8_STAGE
#undef PG8_LDA
#undef PG8_LDB
#undef PG8_MMA
#undef PG8_WAIT_V
#undef PG8_WAIT_L
#undef PG8_BAR
#undef PG8_SCHED
}
}

__device__ __forceinline__ void tr_item(const float* __restrict__ W, int ldw, int k0, int nsrc0, const float* __restrict__ g, bf16_t* WT, int K, int ndst0, LAS float* scr, int lane) {
    const int c4 = lane & 7, r8 = lane >> 3;
    f32x4 v[8];
#pragma unroll
    for (int i = 0; i < 8; ++i) v[i] = *(const f32x4*)(W + (size_t)(k0 + r8 + 8 * i) * ldw + nsrc0 + 4 * c4);
    f32x4 g0 = {1.f, 1.f, 1.f, 1.f}, g1 = g0;
    if (g) { g0 = *(const f32x4*)(g + k0 + 8 * c4); g1 = *(const f32x4*)(g + k0 + 8 * c4 + 4); }
#pragma unroll
    for (int i = 0; i < 8; ++i) *(LAS f32x4*)(scr + (r8 + 8 * i) * 36 + 4 * c4) = v[i];
    LDS_WAIT();
    const int c = lane & 7;
#pragma unroll
    for (int j = 0; j < 4; ++j) { const int n = (lane >> 3) + 8 * j; const LAS float* s = scr + (8 * c) * 36 + n;
        u32x4 o; o.x = pk2(s[0 * 36] * g0[0], s[1 * 36] * g0[1]); o.y = pk2(s[2 * 36] * g0[2], s[3 * 36] * g0[3]); o.z = pk2(s[4 * 36] * g1[0], s[5 * 36] * g1[1]); o.w = pk2(s[6 * 36] * g1[2], s[7 * 36] * g1[3]);
        *(u32x4*)(WT + (size_t)(ndst0 + n) * K + k0 + 8 * c) = o; }
    LDS_WAIT();
}

__device__ __forceinline__ void prologue_phase(const Params& P, LAS unsigned char* lds, const int wid) {
    const int tid = PHASE_TID(wid), lane = tid & 63, wave = wid, nw = blockDim.x >> 6;
    const int gw = blockIdx.x * nw + wave, NGW = gridDim.x * nw;
    LAS float* scr = (LAS float*)lds + wave * (64 * 36);
    constexpr int I_IN = 32 * (NP / 32), I_OUT = 32 * (DM / 32), I_Q = 6 * 24, I_KV = 4 * 32, I_L = I_IN + I_OUT + I_Q + I_KV;
    for (int it = gw; it < 2 * I_L; it += NGW) {
        const int l = it / I_L; int r = it % I_L;
        unsigned char* ws = P.ws;
        if (r < I_IN) { const int nb = r % (NP / 32), kb = r / (NP / 32), n0 = nb * 32; const int ns = n0 >= GATE_COL ? n0 + 8 : n0;
            tr_item(P.in[2] + (size_t)l * DM * NIN, NIN, kb * 64, ns, P.in[1] + l * DM, (bf16_t*)(ws + WS_WIN(l)), DM, n0, scr, lane); continue; }
        r -= I_IN;
        if (r < I_OUT) { const int nb = r % (DM / 32), kb = r / (DM / 32);
            tr_item(P.in[3] + (size_t)l * DM * DM, DM, kb * 64, nb * 32, nullptr, (bf16_t*)(ws + WS_WOUT(l)), DM, nb * 32, scr, lane); continue; }
        r -= I_OUT;
        if (r < I_Q) { const int nb = r % 24, kb = r / 24;
            tr_item(P.in[25] + (size_t)l * 384 * 768, 768, kb * 64, nb * 32, P.in[23] + l * 384, (bf16_t*)(ws + WS_WQ(l)), 384, nb * 32, scr, lane); continue; }
        r -= I_Q;
        { const int nb = r % 32, kb = r / 32;
            tr_item(P.in[26] + (size_t)l * 256 * 1024, 1024, kb * 64, nb * 32, P.in[24] + l * 256, (bf16_t*)(ws + WS_WKV(l)), 256, nb * 32, scr, lane); }
    }
    const int gt = blockIdx.x * blockDim.x + tid, NGT = gridDim.x * blockDim.x;
    for (int i = gt; i < 2 * 8 * DM; i += NGT) { const int l = i / (8 * DM), j = (i / DM) % 8, k = i % DM;
        ((float*)(P.ws + WS_WG(l)))[j * DM + k] = P.in[1][l * DM + k] * P.in[2][(size_t)l * DM * NIN + (size_t)k * NIN + GATE_COL + j]; }
    for (int i = gt; i < 32 * 512; i += NGT) { const int j = i >> 9, c = i & 511; ((bf16_t*)(P.ws + WS_VDNT))[i] = (bf16_t)f2bf(P.in[11][c * 32 + j]); }
    float* rope = (float*)(P.ws + WS_ROPE);
    for (int i = gt; i < TT * 32; i += NGT) { const int t = i >> 5, j = i & 31; const float ang = (float)t * inv_mla(j); double s, c; sincos_d((double)ang, s, c); rope[i] = (float)c; rope[TT * 32 + i] = (float)s; }
    for (int i = gt; i < TT * 8; i += NGT) { const int t = i >> 3, j = i & 7; const float ang = (float)t * inv_da(j); double s, c; sincos_d((double)ang, s, c); rope[2 * TT * 32 + i] = (float)c; rope[2 * TT * 32 + TT * 8 + i] = (float)s; }
}

__device__ __forceinline__ void p1_phase(const Params& P, int l, LAS unsigned char* lds, const int wid) {
    const int tid = PHASE_TID(wid), lane = tid & 63, wave = wid, nw = blockDim.x >> 6;
    const int gw = blockIdx.x * nw + wave, NGW = gridDim.x * nw;
    const float* x = l == 0 ? P.in[0] : P.out;
    bf16_t* xb = (bf16_t*)(P.ws + WS_XB); float* rstd = (float*)(P.ws + WS_RSTD); float* gates = (float*)(P.ws + WS_GATES);
    { const f32x4* wg = (const f32x4*)(P.ws + WS_WG(l)); LAS f32x4* wl = (LAS f32x4*)lds;
#pragma unroll
      for (int i = 0; i < 8; ++i) wl[tid + 512 * i] = wg[tid + 512 * i]; }
    __syncthreads();
    const LAS f32x4* wl = (const LAS f32x4*)lds + lane;
    f32x4 v[8], nx[8];
    if (gw < NTOK) { const f32x4* xr = (const f32x4*)(x + (size_t)gw * DM);
#pragma unroll
        for (int j = 0; j < 8; ++j) nx[j] = xr[lane + 64 * j]; }
    for (int row = gw; row < NTOK; row += NGW) {
        float ss = 0.f;
#pragma unroll
        for (int j = 0; j < 8; ++j) { v[j] = nx[j]; ss += v[j][0] * v[j][0] + v[j][1] * v[j][1] + v[j][2] * v[j][2] + v[j][3] * v[j][3]; }
        if (row + NGW < NTOK) { const f32x4* xr = (const f32x4*)(x + (size_t)(row + NGW) * DM);
#pragma unroll
            for (int j = 0; j < 8; ++j) nx[j] = xr[lane + 64 * j]; }
        ss = wave_sum(ss);
        const float rs = rsqrtf(ss * (1.0f / DM) + 1e-6f);
#pragma unroll
        for (int j = 0; j < 8; ++j) { u32x2 o; o.x = pk2(v[j][0], v[j][1]); o.y = pk2(v[j][2], v[j][3]); *(u32x2*)(xb + (size_t)row * DM + 4 * (lane + 64 * j)) = o; }
        float gv = 0.f;
#pragma unroll 2
        for (int g = 0; g < 8; ++g) { float d = 0.f;
#pragma unroll
            for (int j = 0; j < 8; ++j) { const f32x4 ww = wl[g * 512 + 64 * j]; d += v[j][0] * ww[0] + v[j][1] * ww[1] + v[j][2] * ww[2] + v[j][3] * ww[3]; }
            d = wave_sum(d); if (lane == g) gv = d * rs; }
        if (lane < 8) gates[row * 8 + lane] = gv;
        if (lane == 0) rstd[row] = rs;
    }
    __syncthreads();
}

__device__ __forceinline__ float dppx(float v, const int sel) {
    const int x = __builtin_bit_cast(int, v); int r;
    if (sel == 0) r = __builtin_amdgcn_update_dpp(0, x, 0xB1, 0xF, 0xF, true);
    else if (sel == 1) r = __builtin_amdgcn_update_dpp(0, x, 0x4E, 0xF, 0xF, true);
    else if (sel == 2) r = __builtin_amdgcn_update_dpp(0, x, 0x141, 0xF, 0xF, true);
    else r = __builtin_amdgcn_update_dpp(0, x, 0x140, 0xF, 0xF, true);
    return __builtin_bit_cast(float, r);
}
__device__ __forceinline__ float sum4(float v) { v += dppx(v, 0); v += dppx(v, 1); return v; }
__device__ __forceinline__ float sum8(float v) { v = sum4(v); v += dppx(v, 2); return v; }
__device__ __forceinline__ float sum16(float v) { v = sum8(v); v += dppx(v, 3); return v; }
__device__ __forceinline__ float sum64(float v) {
    v = sum16(v); const int x = __builtin_bit_cast(int, v);
    const float s0 = __builtin_bit_cast(float, __builtin_amdgcn_readlane(x, 0)), s1 = __builtin_bit_cast(float, __builtin_amdgcn_readlane(x, 16));
    const float s2 = __builtin_bit_cast(float, __builtin_amdgcn_readlane(x, 32)), s3 = __builtin_bit_cast(float, __builtin_amdgcn_readlane(x, 48));
    return (s0 + s1) + (s2 + s3);
}
__device__ __forceinline__ float blo(unsigned w) { return __uint_as_float(w << 16); }
__device__ __forceinline__ float bhi(unsigned w) { return __uint_as_float(w & 0xffff0000u); }

__device__ __forceinline__ void vl_phase(const Params& P, const int wid, const int bid, const int G) {
    const int tid = PHASE_TID(wid);
    const int lane = tid & 63, r32 = lane & 31, hh = lane >> 5, nw = blockDim.x >> 6;
    const bf16_t* p = (const bf16_t*)(P.ws + WS_P); const bf16_t* vdt = (const bf16_t*)(P.ws + WS_VDNT); bf16_t* vlb = (bf16_t*)(P.ws + WS_VL);
    const float* mu = P.in[5] + 1 * 1600 + 1024;
    for (int tile = bid * nw + wid; tile < NTOK / 32; tile += G * nw) {
        const int tok = tile * 32 + r32, t = tok % TT;
        const bf16_t* cur = p + (size_t)tok * NP + C_RWV + 8 * hh;
        f32x16 acc;
#pragma unroll
        for (int r = 0; r < 16; ++r) acc[r] = 0.f;
#pragma unroll 4
        for (int ks = 0; ks < 32; ++ks) {
            const u32x4 c4 = *(const u32x4*)(cur + 16 * ks); u32x4 p4 = *(const u32x4*)(cur + 16 * ks - (t > 0 ? NP : 0));
            if (t == 0) p4 = (u32x4){0u, 0u, 0u, 0u};
            const f32x4 m0 = *(const f32x4*)(mu + 16 * ks + 8 * hh), m1 = *(const f32x4*)(mu + 16 * ks + 8 * hh + 4);
            u32x4 w;
            { const float a0 = blo(c4.x), a1 = bhi(c4.x), a2 = blo(c4.y), a3 = bhi(c4.y), b0 = blo(p4.x), b1 = bhi(p4.x), b2 = blo(p4.y), b3 = bhi(p4.y);
              w.x = pk2(a0 + (b0 - a0) * m0[0], a1 + (b1 - a1) * m0[1]); w.y = pk2(a2 + (b2 - a2) * m0[2], a3 + (b3 - a3) * m0[3]); }
            { const float a0 = blo(c4.z), a1 = bhi(c4.z), a2 = blo(c4.w), a3 = bhi(c4.w), b0 = blo(p4.z), b1 = bhi(p4.z), b2 = blo(p4.w), b3 = bhi(p4.w);
              w.z = pk2(a0 + (b0 - a0) * m1[0], a1 + (b1 - a1) * m1[1]); w.w = pk2(a2 + (b2 - a2) * m1[2], a3 + (b3 - a3) * m1[3]); }
            const bf16x8 bfrag = *(const bf16x8*)(vdt + (size_t)r32 * 512 + 16 * ks + 8 * hh);
            acc = __builtin_amdgcn_mfma_f32_32x32x16_bf16(__builtin_bit_cast(bf16x8, w), bfrag, acc, 0, 0, 0);
        }
#pragma unroll
        for (int r = 0; r < 16; ++r) vlb[(size_t)(tile * 32 + (r & 3) + 8 * (r >> 2) + 4 * hh) * 32 + r32] = (bf16_t)f2bf(acc[r]);
    }
}

struct MRaw { unsigned ql[3], kl[2]; u32x2 qw[3], kw[3]; u32x4 v; };
__device__ __forceinline__ void mla_load(MRaw& R, const Params& P, const int tok, const int lane) {
    const int hd = lane >> 4, d0 = 12 * (lane & 15);
    const bf16_t* prow = (const bf16_t*)(P.ws + WS_P) + (size_t)tok * NP;
    const unsigned* ql = (const unsigned*)(prow + C_QLAT) + 3 * lane; const unsigned* kl = (const unsigned*)(prow + C_KVLAT) + 2 * lane;
#pragma unroll
    for (int j = 0; j < 3; ++j) R.ql[j] = ql[j];
#pragma unroll
    for (int j = 0; j < 2; ++j) R.kl[j] = kl[j];
    const u32x2* qrow = (const u32x2*)((const bf16_t*)(P.ws + WS_QRAW) + (size_t)tok * 768 + 192 * hd + d0);
#pragma unroll
    for (int j = 0; j < 3; ++j) R.qw[j] = qrow[j];
    const bf16_t* kvr = (const bf16_t*)(P.ws + WS_KVRAW) + (size_t)tok * 1024 + 256 * hd;
#pragma unroll
    for (int j = 0; j < 3; ++j) { const int d = d0 + 4 * j; const bf16_t* src = d < 128 ? kvr + d : prow + (C_KPE - 128) + d; R.kw[j] = *(const u32x2*)src; }
    R.v = *(const u32x4*)(kvr + 128 + 8 * (lane & 15));
}
__device__ __forceinline__ void mla_proc2(MRaw& RA, MRaw& RB, const Params& P, const int tokA, const int tokB, const int nextA, const int nextB, const int lane, LAS float* sq, LAS float* sk, const float (&gq)[12], const float (&gk)[12]) {
    const int hd = lane >> 4, d0 = 12 * (lane & 15);
    f32x4 cs[2][3], sn[2][3];
#pragma unroll
    for (int t = 0; t < 2; ++t) { const int tk = (t ? tokB : tokA) % TT; const float* cosm = (const float*)(P.ws + WS_ROPE) + tk * 32; const float* sinm = cosm + TT * 32;
#pragma unroll
        for (int k = 0; k < 3; ++k) { const int i = (d0 + 4 * k) & 31; cs[t][k] = *(const f32x4*)(cosm + i); sn[t][k] = *(const f32x4*)(sinm + i); } }
    float xq[2][12], xk[2][12], rskv[2];
#pragma unroll
    for (int t = 0; t < 2; ++t) { const MRaw& R = t ? RB : RA;
        float s1 = 0.f, s2 = 0.f;
#pragma unroll
        for (int j = 0; j < 3; ++j) s1 += blo(R.ql[j]) * blo(R.ql[j]) + bhi(R.ql[j]) * bhi(R.ql[j]);
#pragma unroll
        for (int j = 0; j < 2; ++j) s2 += blo(R.kl[j]) * blo(R.kl[j]) + bhi(R.kl[j]) * bhi(R.kl[j]);
        const float rsq = rsqrtf(sum64(s1) * (1.0f / 384.f) + 1e-6f); rskv[t] = rsqrtf(sum64(s2) * (1.0f / 256.f) + 1e-6f);
        float ssq = 0.f, ssk = 0.f;
#pragma unroll
        for (int j = 0; j < 3; ++j) { xq[t][4 * j] = blo(R.qw[j].x) * rsq; xq[t][4 * j + 1] = bhi(R.qw[j].x) * rsq; xq[t][4 * j + 2] = blo(R.qw[j].y) * rsq; xq[t][4 * j + 3] = bhi(R.qw[j].y) * rsq; }
#pragma unroll
        for (int j = 0; j < 12; ++j) { const int d = d0 + j; const unsigned w_ = (j & 2) ? R.kw[j >> 2].y : R.kw[j >> 2].x; xk[t][j] = ((j & 1) ? bhi(w_) : blo(w_)) * (d < 128 ? rskv[t] : 1.0f); ssq += xq[t][j] * xq[t][j]; ssk += xk[t][j] * xk[t][j]; }
        const float rnq = rsqrtf(sum16(ssq) * (1.0f / 192.f) + 1e-6f), rnk = rsqrtf(sum16(ssk) * (1.0f / 192.f) + 1e-6f);
#pragma unroll
        for (int j = 0; j < 12; ++j) { xq[t][j] *= rnq * gq[j]; xk[t][j] *= rnk * gk[j]; sq[768 * t + 192 * hd + d0 + j] = xq[t][j]; sk[768 * t + 192 * hd + d0 + j] = xk[t][j]; }
    }
    const u32x4 vraw[2] = {RA.v, RB.v};
    if (nextA >= 0) { mla_load(RA, P, nextA, lane); mla_load(RB, P, nextB, lane); }
    LDS_WAIT();
#pragma unroll
    for (int t = 0; t < 2; ++t) { const int tok = t ? tokB : tokA;
#pragma unroll
        for (int j = 0; j < 12; ++j) { const int d = d0 + j;
            const int dp = d < 128 ? d : (d < 160 ? d + 32 : d - 32);
            const float pq = sq[768 * t + 192 * hd + dp], pk = sk[768 * t + 192 * hd + dp];
            const float c_ = cs[t][j >> 2][j & 3], s_ = sn[t][j >> 2][j & 3];
            const float sg = d < 128 ? 0.f : (d < 160 ? -s_ : s_), cg = d < 128 ? 1.f : c_;
            xq[t][j] = xq[t][j] * cg + pq * sg; xk[t][j] = xk[t][j] * cg + pk * sg; }
        u32x2* qrow = (u32x2*)((bf16_t*)(P.ws + WS_QRAW) + (size_t)tok * 768 + 192 * hd + d0);
        u32x2* krow = (u32x2*)((bf16_t*)(P.ws + WS_KMLA) + (size_t)tok * 768 + 192 * hd + d0);
#pragma unroll
        for (int j = 0; j < 3; ++j) { u32x2 a_, b2; a_.x = pk2(xq[t][4 * j], xq[t][4 * j + 1]); a_.y = pk2(xq[t][4 * j + 2], xq[t][4 * j + 3]); b2.x = pk2(xk[t][4 * j], xk[t][4 * j + 1]); b2.y = pk2(xk[t][4 * j + 2], xk[t][4 * j + 3]); qrow[j] = a_; krow[j] = b2; }
        { u32x4 v = vraw[t];
#pragma unroll
          for (int j = 0; j < 4; ++j) v[j] = pk2(blo(v[j]) * rskv[t], bhi(v[j]) * rskv[t]);
          *(u32x4*)((bf16_t*)(P.ws + WS_KVRAW) + (size_t)tok * 1024 + 256 * hd + 128 + 8 * (lane & 15)) = v; }
    }
    LDS_WAIT();
}
__device__ __forceinline__ void mla_prep_phase(const Params& P, int l, LAS unsigned char* lds, const int wid, const int bid, const int G) {
    const int tid = PHASE_TID(wid);
    const int lane = tid & 63, nw = blockDim.x >> 6, d0 = 12 * (lane & 15);
    LAS float* sq = (LAS float*)lds + wid * 3072; LAS float* sk = sq + 1536;
    const float* qg = P.in[27] + l * 192 + d0; const float* kg = P.in[28] + l * 192 + d0;
    float gq[12], gk[12];
#pragma unroll
    for (int j = 0; j < 12; ++j) { gq[j] = qg[j]; gk[j] = kg[j]; }
    const int stride = G * nw; int tok = bid * nw + wid;
    MRaw RA, RB;
    if (tok < NTOK) { mla_load(RA, P, tok, lane); mla_load(RB, P, tok + stride < NTOK ? tok + stride : tok, lane); }
#pragma unroll 1
    while (tok < NTOK) {
        const int tB = tok + stride < NTOK ? tok + stride : tok;
        const int nA = tok + 2 * stride, nB = nA + stride < NTOK ? nA + stride : nA;
        mla_proc2(RA, RB, P, tok, tB, nA < NTOK ? nA : -1, nB, lane, sq, sk, gq, gk);
        tok = nA;
    }
}

struct DRaw { u32x4 a, b; f32x4 c0, c1, s0, s1; };
__device__ __forceinline__ void da_load(DRaw& R, const Params& P, const int tok, const int lane) {
    const u32x4* ptr = (const u32x4*)((const bf16_t*)(P.ws + WS_P) + (size_t)tok * NP + C_DAQ + 16 * lane);
    R.a = ptr[0]; R.b = ptr[1];
    const float* cosd = (const float*)(P.ws + WS_ROPE) + 2 * TT * 32 + (tok % TT) * 8; const float* sind = cosd + TT * 8;
    R.c0 = *(const f32x4*)cosd; R.c1 = *(const f32x4*)(cosd + 4); R.s0 = *(const f32x4*)sind; R.s1 = *(const f32x4*)(sind + 4);
}
__device__ __forceinline__ void da_proc(const DRaw& R, const Params& P, const int tok, const int lane, const float (&gv)[16]) {
    float x[16];
#pragma unroll
    for (int j = 0; j < 4; ++j) { x[2 * j] = blo(R.a[j]); x[2 * j + 1] = bhi(R.a[j]); x[8 + 2 * j] = blo(R.b[j]); x[8 + 2 * j + 1] = bhi(R.b[j]); }
    float ss = 0.f;
#pragma unroll
    for (int j = 0; j < 16; ++j) ss += x[j] * x[j];
    const float r = rsqrtf(sum4(ss) * (1.0f / 64.f) + 1e-6f);
#pragma unroll
    for (int j = 0; j < 16; ++j) x[j] *= r * gv[j];
    const bool rot = (lane & 3) == 0;
#pragma unroll
    for (int i = 0; i < 8; ++i) { const float c = i < 4 ? R.c0[i & 3] : R.c1[i & 3], sn = i < 4 ? R.s0[i & 3] : R.s1[i & 3];
        const float x1 = x[i], x2 = x[8 + i]; const float y1 = x1 * c - x2 * sn, y2 = x2 * c + x1 * sn; x[i] = rot ? y1 : x1; x[8 + i] = rot ? y2 : x2; }
    u32x4 oa, ob;
#pragma unroll
    for (int j = 0; j < 4; ++j) { oa[j] = pk2(x[2 * j], x[2 * j + 1]); ob[j] = pk2(x[8 + 2 * j], x[8 + 2 * j + 1]); }
    u32x4* ptr = (u32x4*)((bf16_t*)(P.ws + WS_P) + (size_t)tok * NP + C_DAQ + 16 * lane);
    ptr[0] = oa; ptr[1] = ob;
}
__device__ __forceinline__ void da_prep_phase(const Params& P, int l, const int wid, const int bid, const int G) {
    const int tid = PHASE_TID(wid);
    const int lane = tid & 63, nw = blockDim.x >> 6;
    const float* g = (lane < 32 ? P.in[29] : P.in[30]) + l * 64 + 16 * (lane & 3);
    float gv[16];
#pragma unroll
    for (int j = 0; j < 16; ++j) gv[j] = g[j];
    const int stride = G * nw; int tok = bid * nw + wid;
    DRaw R0, R1, R2, R3;
    if (tok < NTOK) da_load(R0, P, tok, lane);
    if (tok + stride < NTOK) da_load(R1, P, tok + stride, lane);
#pragma unroll 1
    for (; tok < NTOK; tok += 4 * stride) {
        if (tok + 2 * stride < NTOK) da_load(R2, P, tok + 2 * stride, lane);
        if (tok + 3 * stride < NTOK) da_load(R3, P, tok + 3 * stride, lane);
        if (tok + stride < NTOK) { da_proc(R0, P, tok, lane, gv); da_proc(R1, P, tok + stride, lane, gv); }
        else da_proc(R0, P, tok, lane, gv);
        if (tok + 2 * stride < NTOK) {
            if (tok + 4 * stride < NTOK) da_load(R0, P, tok + 4 * stride, lane);
            if (tok + 5 * stride < NTOK) da_load(R1, P, tok + 5 * stride, lane);
            if (tok + 3 * stride < NTOK) { da_proc(R2, P, tok + 2 * stride, lane, gv); da_proc(R3, P, tok + 3 * stride, lane, gv); }
            else da_proc(R2, P, tok + 2 * stride, lane, gv);
        }
    }
}

namespace att {
typedef short s16x4 __attribute__((ext_vector_type(4)));
typedef float f32x2_t __attribute__((ext_vector_type(2))); typedef __bf16 bf16x2_t __attribute__((ext_vector_type(2)));
__device__ __forceinline__ unsigned cvtpk(float lo, float hi) { f32x2_t v = {lo, hi}; bf16x2_t b = __builtin_convertvector(v, bf16x2_t); return __builtin_bit_cast(unsigned, b); }
__device__ __forceinline__ s16x4 vtr(LAS unsigned char* p) { return __builtin_bit_cast(s16x4, __builtin_amdgcn_ds_read_tr16_b64_v4i16((LAS s16x4*)p)); }
#define MFMA32(a, b, c) __builtin_amdgcn_mfma_f32_32x32x16_bf16((a), (b), (c), 0, 0, 0)
constexpr int VPITCH = 320;
constexpr int UNIT_OFF = 140 * 1024;

template <int DQK>
__device__ __forceinline__ void flash_map(LAS unsigned char* lds, const bf16_t* Qp, int qpitch, const bf16_t* Kp, int kpitch, const bf16_t* Vp, int vpitch,
                                          size_t tokb, int q0, float sc, f32x16 (&o)[4], const int wid, const int tid) {
    constexpr int KP = DQK * 2 + 16, KBUF = 64 * KP, VBUF = 64 * VPITCH, CPR = DQK / 8, KCH = (64 * CPR) / 512, NKS = DQK / 16;
    const int lane = tid & 63, r32 = lane & 31, hh = lane >> 5;
    constexpr int NPF = DQK == 192 ? 2 : 4;
    constexpr int NKP = DQK == 192 ? 2 : 4;
    constexpr int NKR = DQK == 192 ? 7 : NKS;
    constexpr int QL_OFF = 2 * (64 * (DQK * 2 + 16)) + 2 * (64 * VPITCH), QLP = 176;
    bf16x8 qf[NKR];
    LAS unsigned char* qlds = lds + QL_OFF + wid * (32 * QLP) + r32 * QLP + 16 * hh;
    { const bf16_t* qrow = Qp + (tokb + q0 + 32 * wid + r32) * qpitch + 8 * hh;
#pragma unroll
      for (int ks = 0; ks < NKS; ++ks) { const bf16x8 v = *(const bf16x8*)(qrow + 16 * ks); if (ks < NKR) qf[ks < NKR ? ks : 0] = v; else *(LAS bf16x8*)(qlds + 32 * (ks - NKR)) = v; } }
    const int nkt = (q0 + 256) / 64;
    u32x4 kr[KCH], vr[2];
    int koff[KCH], kl[KCH], voff[2], vl_[2];
#pragma unroll
    for (int i = 0; i < KCH; ++i) { const int c = tid + 512 * i, row = c / CPR, col = c % CPR; koff[i] = row * kpitch + col * 8; kl[i] = row * KP + col * 16; }
#pragma unroll
    for (int i = 0; i < 2; ++i) { const int c = tid + 512 * i, row = c >> 4, col = c & 15; voff[i] = row * vpitch + col * 8; vl_[i] = 2 * KBUF + row * VPITCH + col * 16; }
#define ATT_GLOADK(kt) do { const bf16_t* kt_ = Kp + (tokb + 64 * (kt)) * kpitch; \
        _Pragma("unroll") for (int i_ = 0; i_ < KCH; ++i_) kr[i_] = *(const u32x4*)(kt_ + koff[i_]); } while (0)
#define ATT_GLOADV(kt) do { const bf16_t* vt_ = Vp + (tokb + 64 * (kt)) * vpitch; \
        _Pragma("unroll") for (int i_ = 0; i_ < 2; ++i_) vr[i_] = *(const u32x4*)(vt_ + voff[i_]); } while (0)
#define ATT_LWRITEK(buf) do { _Pragma("unroll") for (int i_ = 0; i_ < KCH; ++i_) *(LAS u32x4*)(lds + (buf) * KBUF + kl[i_]) = kr[i_]; } while (0)
#define ATT_LWRITEV(buf) do { _Pragma("unroll") for (int i_ = 0; i_ < 2; ++i_) *(LAS u32x4*)(lds + (buf) * VBUF + vl_[i_]) = vr[i_]; } while (0)
    float m_run = -INFINITY, l_run = 0.f;
#pragma unroll
    for (int vb = 0; vb < 4; ++vb)
#pragma unroll
        for (int r = 0; r < 16; ++r) o[vb][r] = 0.f;
    { u32x4 k1_[KCH]; const bf16_t* kt1_ = Kp + (tokb + 64) * kpitch;
      ATT_GLOADK(0); ATT_GLOADV(0);
#pragma unroll
      for (int i = 0; i < KCH; ++i) k1_[i] = *(const u32x4*)(kt1_ + koff[i]);
      ATT_LWRITEK(0); ATT_LWRITEV(0);
#pragma unroll
      for (int i = 0; i < KCH; ++i) *(LAS u32x4*)(lds + KBUF + kl[i]) = k1_[i]; }
    if (nkt > 2) ATT_GLOADK(2);
    ATT_GLOADV(1);
    __syncthreads();
    const int qw0 = q0 + 32 * wid, qg = qw0 + r32;
    const int g16 = lane >> 4, i16 = lane & 15;
    const int vlane_off = ((i16 >> 2) + 4 * hh) * VPITCH + (16 * (g16 & 1) + 4 * (i16 & 3)) * 2;
#define ATT_QK(SV, kt_, kb_) do { LAS unsigned char* kbase_ = lds + ((kt_) & 1) * KBUF + (32 * (kb_) + r32) * KP + 16 * hh; \
        _Pragma("unroll") for (int r_ = 0; r_ < 16; ++r_) SV[r_] = 0.f; \
        bf16x8 ka_[NKP];     \
        _Pragma("unroll") for (int ks = 0; ks < NKP; ++ks) ka_[ks] = *(const LAS bf16x8*)(kbase_ + 32 * ks); \
        _Pragma("unroll") for (int ks = 0; ks < NKS; ++ks) { \
            const bf16x8 bq_ = ks < NKR ? qf[ks < NKR ? ks : 0] : *(const LAS bf16x8*)(qlds + 32 * (ks - NKR)); SV = MFMA32(ka_[ks % NKP], bq_, SV); \
            if (ks + NKP < NKS) ka_[ks % NKP] = *(const LAS bf16x8*)(kbase_ + 32 * (ks + NKP)); } } while (0)
#define ATT_EXP(SV, PF) do { float ps_ = 0.f; \
        _Pragma("unroll") for (int r_ = 0; r_ < 16; ++r_) { SV[r_] = __builtin_amdgcn_exp2f(SV[r_] * sc - m_run); ps_ += SV[r_]; } \
        l_run += ps_; \
        _Pragma("unroll") for (int s2 = 0; s2 < 2; ++s2) { u32x4 w_; _Pragma("unroll") for (int j = 0; j < 4; ++j) w_[j] = cvtpk(SV[8 * s2 + 2 * j], SV[8 * s2 + 2 * j + 1]); PF[s2] = __builtin_bit_cast(bf16x8, w_); } } while (0)
#define ATT_PV(PF, kb_) do { LAS unsigned char* vbase_ = lds + 2 * KBUF + (kt & 1) * VBUF + vlane_off + (32 * (kb_)) * VPITCH; \
        bf16x8 vf_[NPF];     \
        _Pragma("unroll") for (int i_ = 0; i_ < NPF; ++i_) { const s16x4 lo_ = vtr(vbase_ + (16 * (i_ >> 2)) * VPITCH + 64 * (i_ & 3)), hi_ = vtr(vbase_ + (16 * (i_ >> 2) + 8) * VPITCH + 64 * (i_ & 3)); \
            vf_[i_] = __builtin_shufflevector(lo_, hi_, 0, 1, 2, 3, 4, 5, 6, 7); } \
        _Pragma("unroll") for (int i_ = 0; i_ < 8; ++i_) { \
            o[i_ & 3] = MFMA32(vf_[i_ % NPF], PF[i_ >> 2], o[i_ & 3]); \
            if (i_ + NPF < 8) { const int n_ = i_ + NPF; const s16x4 lo_ = vtr(vbase_ + (16 * (n_ >> 2)) * VPITCH + 64 * (n_ & 3)), hi_ = vtr(vbase_ + (16 * (n_ >> 2) + 8) * VPITCH + 64 * (n_ & 3)); \
                vf_[i_ % NPF] = __builtin_shufflevector(lo_, hi_, 0, 1, 2, 3, 4, 5, 6, 7); } } } while (0)
#define ATT_RESCALE(mx_) do { if (__any((mx_) > m_run + 8.0f)) { const float m_new_ = fmaxf(m_run, (mx_)); const float alpha_ = __builtin_amdgcn_exp2f(m_run - m_new_); m_run = m_new_; l_run *= alpha_; \
            _Pragma("unroll") for (int vb = 0; vb < 4; ++vb) _Pragma("unroll") for (int r_ = 0; r_ < 16; ++r_) o[vb][r_] *= alpha_; } } while (0)
#define ATT_SMPV(SV, kb_) do { const int k0_ = 64 * kt + 32 * (kb_); float mx_ = -INFINITY; \
        if (k0_ + 31 > qw0) { _Pragma("unroll") for (int r_ = 0; r_ < 16; ++r_) { const int key_ = k0_ + (r_ & 3) + 8 * (r_ >> 2) + 4 * hh; SV[r_] = key_ > qg ? -INFINITY : SV[r_]; mx_ = fmaxf(mx_, SV[r_]); } } \
        else { _Pragma("unroll") for (int r_ = 0; r_ < 16; ++r_) mx_ = fmaxf(mx_, SV[r_]); } \
        mx_ = xor32_max_fast(mx_) * sc; \
        ATT_RESCALE(mx_); \
        bf16x8 pf_[2]; ATT_EXP(SV, pf_); ATT_PV(pf_, kb_); } while (0)
    const int nfull = q0 >> 6;
    f32x16 s0, s1;
    ATT_QK(s0, 0, 0);
    { float mx_ = s0[0];
#pragma unroll
      for (int r = 1; r < 16; ++r) mx_ = fmaxf(mx_, s0[r]);
      mx_ = xor32_max_fast(mx_) * sc; ATT_RESCALE(mx_); }
#define ATT_E1(SC, r_) do { SC[r_] = __builtin_amdgcn_exp2f(SC[r_] * sc - m_run); ps_ += SC[r_]; } while (0)
#define ATT_CV(SC, w_) (cvtpk(SC[2 * (w_)], SC[2 * (w_) + 1]))
#define ATT_STEP(SC, SN, ktn_, kbn_, kbv_, ktnn_, kbnn_) do { \
        LAS unsigned char* kbase_ = lds + ((ktn_) & 1) * KBUF + (32 * (kbn_) + r32) * KP + 16 * hh; \
        LAS unsigned char* knext_ = lds + ((ktnn_) & 1) * KBUF + (32 * (kbnn_) + r32) * KP + 16 * hh;     \
        LAS unsigned char* vbase_ = lds + 2 * KBUF + (kt & 1) * VBUF + vlane_off + (32 * (kbv_)) * VPITCH; \
        bf16x8 vf_[NPF]; u32x4 pw0_, pw1_; float ps_ = 0.f; \
        _Pragma("unroll") for (int r_ = 0; r_ < 16; ++r_) SN[r_] = 0.f; \
        __builtin_amdgcn_sched_barrier(0); \
        _Pragma("unroll") for (int ks = 0; ks < NKS; ++ks) { \
            const bf16x8 bq_ = ks < NKR ? qf[ks < NKR ? ks : 0] : *(const LAS bf16x8*)(qlds + 32 * (ks - NKR)); SN = MFMA32(ka_[ks % NKP], bq_, SN); \
            if (ks + NKP < NKS) ka_[ks % NKP] = *(const LAS bf16x8*)(kbase_ + 32 * (ks + NKP)); \
            if (NKS == 4) { ATT_E1(SC, 2 * ks); ATT_E1(SC, 2 * ks + 1); pw0_[ks] = ATT_CV(SC, ks); } \
            else { if (ks < 8) ATT_E1(SC, ks < 8 ? ks : 0); else pw0_[ks < 8 ? 0 : ks - 8] = ATT_CV(SC, ks < 8 ? 0 : ks - 8); } \
            if (ks >= NKS - (NPF / 2) ) { _Pragma("unroll") for (int i_ = 2 * (ks - (NKS - NPF / 2)); i_ < 2 * (ks - (NKS - NPF / 2)) + 2; ++i_) { \
                const s16x4 lo_ = vtr(vbase_ + (16 * (i_ >> 2)) * VPITCH + 64 * (i_ & 3)), hi_ = vtr(vbase_ + (16 * (i_ >> 2) + 8) * VPITCH + 64 * (i_ & 3)); \
                vf_[i_] = __builtin_shufflevector(lo_, hi_, 0, 1, 2, 3, 4, 5, 6, 7); } } \
            __builtin_amdgcn_sched_barrier(0); } \
        float mxn_ = SN[0]; \
        _Pragma("unroll") for (int i_ = 0; i_ < 8; ++i_) { \
            o[i_ & 3] = MFMA32(vf_[i_ % NPF], __builtin_bit_cast(bf16x8, i_ < 4 ? pw0_ : pw1_), o[i_ & 3]); \
            if (i_ + NPF < 8) { const int n_ = i_ + NPF; const s16x4 lo_ = vtr(vbase_ + (16 * (n_ >> 2)) * VPITCH + 64 * (n_ & 3)), hi_ = vtr(vbase_ + (16 * (n_ >> 2) + 8) * VPITCH + 64 * (n_ & 3)); \
                vf_[i_ % NPF] = __builtin_shufflevector(lo_, hi_, 0, 1, 2, 3, 4, 5, 6, 7); } \
            if (i_ < 4) { ATT_E1(SC, 8 + 2 * (i_ & 3)); ATT_E1(SC, 9 + 2 * (i_ & 3)); pw1_[i_ & 3] = ATT_CV(SC, 4 + (i_ & 3)); } \
            else { const int b_ = 4 * (i_ & 3); mxn_ = fmaxf(fmaxf(mxn_, SN[b_ + (b_ == 0 ? 1 : 0)]), fmaxf(SN[b_ + 1], fmaxf(SN[b_ + 2], SN[b_ + 3]))); \
                   if ((i_ & 3) < NKP) ka_[i_ & 3] = *(const LAS bf16x8*)(knext_ + 32 * (i_ & 3)); } \
            __builtin_amdgcn_sched_barrier(0); } \
        l_run += ps_; \
        mxn_ = xor32_max_fast(mxn_) * sc; ATT_RESCALE(mxn_); } while (0)
    int kt = 0;
    bf16x8 ka_[NKP];
    if (nfull > 0) { LAS unsigned char* kb0_ = lds + (32 + r32) * KP + 16 * hh;
#pragma unroll
        for (int ks = 0; ks < NKP; ++ks) ka_[ks] = *(const LAS bf16x8*)(kb0_ + 32 * ks); }
#pragma unroll 1
    for (; kt < nfull; ++kt) {
        if (kt + 1 < nkt) { ATT_LWRITEV((kt + 1) & 1); if (kt + 2 < nkt) ATT_GLOADV(kt + 2); }
        ATT_STEP(s0, s1, kt, 1, 0, kt + 1, 0);
        LDS_BARRIER();
        if (kt + 2 < nkt) { ATT_LWRITEK(kt & 1); if (kt + 3 < nkt) ATT_GLOADK(kt + 3); }
        ATT_STEP(s1, s0, kt + 1, 0, 1, kt + 1, 1);
        LDS_BARRIER();
    }
#pragma unroll 1
    for (; kt < nkt; ++kt) {
        if (kt + 1 < nkt) { ATT_LWRITEV((kt + 1) & 1); if (kt + 2 < nkt) ATT_GLOADV(kt + 2); }
        const bool do0 = 64 * kt <= qw0 + 31, do1 = 64 * kt + 32 <= qw0 + 31;
        if (do1) ATT_QK(s1, kt, 1);
        if (do0) ATT_SMPV(s0, 0);
        LDS_BARRIER();
        if (kt + 2 < nkt) { ATT_LWRITEK(kt & 1); if (kt + 3 < nkt) ATT_GLOADK(kt + 3); }
        if (kt + 1 < nkt && 64 * (kt + 1) <= qw0 + 31) ATT_QK(s0, kt + 1, 0);
        if (do1) ATT_SMPV(s1, 1);
        LDS_BARRIER();
    }
#undef ATT_STEP
#undef ATT_E1
#undef ATT_CV
#undef ATT_EXP
#undef ATT_PV
#undef ATT_RESCALE
#undef ATT_QK
#undef ATT_SMPV
#undef ATT_GLOADK
#undef ATT_GLOADV
#undef ATT_LWRITEK
#undef ATT_LWRITEV
    l_run = xor32_sum(l_run);
    const float il = 1.0f / l_run;
#pragma unroll
    for (int vb = 0; vb < 4; ++vb)
#pragma unroll
        for (int r = 0; r < 16; ++r) o[vb][r] *= il;
}

__device__ __forceinline__ void attn_phase(const Params& P, int l, LAS unsigned char* lds, unsigned* counter, const int wid) {
    const float LOG2E = 1.4426950408889634f;
    const bf16_t* p = (const bf16_t*)(P.ws + WS_P); bf16_t* y = (bf16_t*)(P.ws + WS_XB);
    const float beta = P.in[4][l * 4 + 2];
    float d1 = 0.f, d2 = 0.f;
    for (int i = 0; i < 64; ++i) { d1 += P.in[31][l * 64 + i] * P.in[32][l * 64 + i]; d2 += P.in[33][l * 64 + i] * P.in[34][l * 64 + i]; }
    const float lam_init = 0.8f - 0.6f * expf(-0.3f * (float)l); const float lam = expf(d1) - expf(d2) + lam_init;
    const float post = (1.0f - lam_init) * P.in[4][l * 4 + 3];
    const float* sg = P.in[35] + l * 128;
#define ATT_SGPRF(x) __builtin_bit_cast(float, __builtin_amdgcn_readfirstlane(__builtin_bit_cast(int, (x))))
    const float beta_s = ATT_SGPRF(beta), lam_s = ATT_SGPRF(lam), post_s = ATT_SGPRF(post);
#undef ATT_SGPRF
    const unsigned long long T0 = 0xda78aef97f635cfull, T1 = 0x1d4962dcd8c9f48ull, T2 = 0x8022190a74ull;
    for (;;) {
        { const int tid0 = PHASE_TID(wid); unsigned* c_ = counter; OPAQUE_S(c_); if (tid0 == 0) *(LAS unsigned*)(lds + UNIT_OFF) = atomicAdd(c_, 1u); }
        __syncthreads();
        const unsigned u = (unsigned)__builtin_amdgcn_readfirstlane((int)*(LAS unsigned*)(lds + UNIT_OFF));
        __syncthreads();
        if (u >= 512u) break;
        const unsigned r = u >> 4; const unsigned e = (unsigned)((r < 12u ? T0 >> (5u * r) : (r < 24u ? T1 >> (5u * (r - 12u)) : T2 >> (5u * (r - 24u)))) & 31ull);
        const int qb = (int)(e & 15u), bh = u & 15, b = bh >> 2, h = bh & 3, q0 = qb * 256;
        const size_t tokb = (size_t)b * TT;
        if (e & 16u) {
            const int tid = PHASE_TID(wid);
            f32x16 o[4];
            flash_map<192>(lds, (const bf16_t*)(P.ws + WS_QRAW) + 192 * h, 768, (const bf16_t*)(P.ws + WS_KMLA) + 192 * h, 768, (const bf16_t*)(P.ws + WS_KVRAW) + 256 * h + 128, 1024, tokb, q0, 0.07216878364870322f * LOG2E, o, wid, tid);
            const int lane = lane_id_opaque(), r32 = lane & 31, hh = lane >> 5;
            const size_t tok = tokb + q0 + 32 * wid + r32;
            const bf16_t* zr = p + tok * NP + C_Z + Y_MLA + 128 * h; bf16_t* yr = y + tok * DM + Y_MLA + 128 * h;
#pragma unroll
            for (int vb = 0; vb < 4; ++vb)
#pragma unroll
                for (int g = 0; g < 4; ++g) { const int vd = 32 * vb + 8 * g + 4 * hh; const u32x2 zz = *(const u32x2*)(zr + vd);
                    const float z0 = __uint_as_float(zz.x << 16), z1 = __uint_as_float(zz.x & 0xffff0000u), z2 = __uint_as_float(zz.y << 16), z3 = __uint_as_float(zz.y & 0xffff0000u);
                    u32x2 w; w.x = pk2(beta_s * o[vb][4 * g] * (z0 / (1.0f + __expf(-z0))), beta_s * o[vb][4 * g + 1] * (z1 / (1.0f + __expf(-z1))));
                    w.y = pk2(beta_s * o[vb][4 * g + 2] * (z2 / (1.0f + __expf(-z2))), beta_s * o[vb][4 * g + 3] * (z3 / (1.0f + __expf(-z3))));
                    *(u32x2*)(yr + vd) = w; }
        } else {
            const int tid = PHASE_TID(wid);
            f32x16 o[4];
            flash_map<64>(lds, p + C_DAQ + 128 * h, NP, p + C_DAK + 128 * h, NP, p + C_DAV + 128 * h, NP, tokb, q0, 0.125f * LOG2E, o, wid, tid);
            const int lane = lane_id_opaque(), r32 = lane & 31, hh = lane >> 5;
            LAS unsigned* stash = (LAS unsigned*)(lds + 61440) + wid * 2048 + lane;
#pragma unroll
            for (int vb = 0; vb < 4; ++vb)
#pragma unroll
                for (int j = 0; j < 8; ++j) stash[(vb * 8 + j) * 64] = cvtpk(o[vb][2 * j], o[vb][2 * j + 1]);
            flash_map<64>(lds, p + C_DAQ + 128 * h + 64, NP, p + C_DAK + 128 * h + 64, NP, p + C_DAV + 128 * h, NP, tokb, q0, 0.125f * LOG2E, o, wid, tid);
            float ss = 0.f;
#pragma unroll
            for (int vb = 0; vb < 4; ++vb)
#pragma unroll
                for (int j = 0; j < 8; ++j) { const unsigned w = stash[(vb * 8 + j) * 64];
                    o[vb][2 * j] = __uint_as_float(w << 16) - lam_s * o[vb][2 * j]; o[vb][2 * j + 1] = __uint_as_float(w & 0xffff0000u) - lam_s * o[vb][2 * j + 1];
                    ss += o[vb][2 * j] * o[vb][2 * j] + o[vb][2 * j + 1] * o[vb][2 * j + 1]; }
            ss = xor32_sum(ss);
            const float rs = rsqrtf(ss * (1.0f / 128.f) + 1e-6f) * post_s;
            const size_t tok = tokb + q0 + 32 * wid + r32;
            const bf16_t* zr = p + tok * NP + C_Z + Y_DA + 128 * h; bf16_t* yr = y + tok * DM + Y_DA + 128 * h;
#pragma unroll
            for (int vb = 0; vb < 4; ++vb)
#pragma unroll
                for (int g = 0; g < 4; ++g) { const int vd = 32 * vb + 8 * g + 4 * hh; const u32x2 zz = *(const u32x2*)(zr + vd); const f32x4 gg = *(const f32x4*)(sg + vd);
                    const float z0 = __uint_as_float(zz.x << 16), z1 = __uint_as_float(zz.x & 0xffff0000u), z2 = __uint_as_float(zz.y << 16), z3 = __uint_as_float(zz.y & 0xffff0000u);
                    u32x2 w; w.x = pk2(rs * gg[0] * o[vb][4 * g] * (z0 / (1.0f + __expf(-z0))), rs * gg[1] * o[vb][4 * g + 1] * (z1 / (1.0f + __expf(-z1))));
                    w.y = pk2(rs * gg[2] * o[vb][4 * g + 2] * (z2 / (1.0f + __expf(-z2))), rs * gg[3] * o[vb][4 * g + 3] * (z3 / (1.0f + __expf(-z3))));
                    *(u32x2*)(yr + vd) = w; }
        }
    }
}
}

namespace wkv {
constexpr int BUF = 6 * 8192;
constexpr int O_W = 0, O_NKK = 8192, O_KKA = 16384, O_KP = 24576, O_R = 32768, O_V = 40960;
constexpr int O_YB = 2 * BUF, O_BON = O_YB + 8192, O_LORA = O_BON + 256, O_MU = O_LORA + 3 * 4096, O_CST = O_MU + 256, O_DSC = O_CST + 9 * 256, O_END = O_DSC + 4 * 3 * 8 * 64 * 4;
static_assert(O_END <= 147456 - 16, "wkv LDS map");
__device__ __forceinline__ float dppf(float v, const int sel) {
    const int x = __builtin_bit_cast(int, v); int r;
    if (sel == 0) r = __builtin_amdgcn_update_dpp(0, x, 0xB1, 0xF, 0xF, true);
    else if (sel == 1) r = __builtin_amdgcn_update_dpp(0, x, 0x4E, 0xF, 0xF, true);
    else if (sel == 2) r = __builtin_amdgcn_update_dpp(0, x, 0x141, 0xF, 0xF, true);
    else r = __builtin_amdgcn_update_dpp(0, x, 0x140, 0xF, 0xF, true);
    return __builtin_bit_cast(float, r);
}
__device__ __forceinline__ float red8(float v) { v += dppf(v, 0); v += dppf(v, 1); v += dppf(v, 2); return v; }
__device__ __forceinline__ float wsum(float v) {
    v += dppf(v, 0); v += dppf(v, 1); v += dppf(v, 2); v += dppf(v, 3);
    const int x = __builtin_bit_cast(int, v);
    const float s0 = __builtin_bit_cast(float, __builtin_amdgcn_readlane(x, 0)), s1 = __builtin_bit_cast(float, __builtin_amdgcn_readlane(x, 16));
    const float s2 = __builtin_bit_cast(float, __builtin_amdgcn_readlane(x, 32)), s3 = __builtin_bit_cast(float, __builtin_amdgcn_readlane(x, 48));
    return (s0 + s1) + (s2 + s3);
}
__device__ __forceinline__ float fsig(float x) { return __builtin_amdgcn_rcpf(1.0f + __expf(-x)); }
typedef float f32x2 __attribute__((ext_vector_type(2)));
#define V2LO(x) __builtin_shufflevector(x, x, 0, 1)
#define V2HI(x) __builtin_shufflevector(x, x, 2, 3)
struct Ops { f32x4 w, n, a, k, r; float vv; };
__device__ __forceinline__ void load_ops(Ops& o, LAS unsigned char* bk, LAS unsigned char* bv, int tt) {
    const int off = tt * 256;
    o.w = *(const LAS f32x4*)(bk + O_W + off); o.n = *(const LAS f32x4*)(bk + O_NKK + off); o.a = *(const LAS f32x4*)(bk + O_KKA + off);
    o.k = *(const LAS f32x4*)(bk + O_KP + off); o.r = *(const LAS f32x4*)(bk + O_R + off);
    o.vv = *(const LAS float*)(bv + off);
}
__device__ __forceinline__ float red16(float v) { v += dppf(v, 0); v += dppf(v, 1); v += dppf(v, 2); v += dppf(v, 3); return v; }
__device__ __forceinline__ void step(const Ops& o, const f32x4 rprev, f32x2 (&S)[2], LAS float* by, int tt) {
    f32x2 p = S[0] * V2LO(o.n); p = S[1] * V2HI(o.n) + p;
    f32x2 u = S[0] * V2LO(rprev); u = S[1] * V2HI(rprev) + u;
    float sa = p.x + p.y, yv = u.x + u.y;
    sa += dppf(sa, 0); yv += dppf(yv, 0); sa += dppf(sa, 1); yv += dppf(yv, 1); sa += dppf(sa, 2); yv += dppf(yv, 2); sa += dppf(sa, 3); yv += dppf(yv, 3);
    const f32x2 sav = {sa, sa}, vvv = {o.vv, o.vv};
    S[0] = S[0] * V2LO(o.w) + (sav * V2LO(o.a) + vvv * V2LO(o.k));
    S[1] = S[1] * V2HI(o.w) + (sav * V2HI(o.a) + vvv * V2HI(o.k));
    if (tt > 0) by[(tt - 1) * 16] = yv;
}

struct HRaw { u32x4 rc, kc, vc, rp, kp, vp, vf; u32x4 wd[2], ad[2], vlp[2]; };
__device__ __forceinline__ void h_load(HRaw& R, const Params& P, const int b, const int h, const int hw, const int lane, const int cc) {
    const bf16_t* p = (const bf16_t*)(P.ws + WS_P); const bf16_t* vfirst = (const bf16_t*)(P.ws + WS_VFIRST);
    const int hh = lane >> 5, c32 = lane & 31, tt = lane >> 3, cg = lane & 7, t0 = cc * 32 + 8 * hw; const size_t tokb = (size_t)b * TT + t0;
    const bf16_t* row = p + (tokb + tt) * NP + 64 * h + 8 * cg;
    const int pm = (t0 + tt) > 0 ? NP : 0;
    R.rc = *(const u32x4*)(row + C_RWR); R.kc = *(const u32x4*)(row + C_RWK); R.vc = *(const u32x4*)(row + C_RWV);
    R.rp = *(const u32x4*)(row - pm + C_RWR); R.kp = *(const u32x4*)(row - pm + C_RWK); R.vp = *(const u32x4*)(row - pm + C_RWV);
    R.vf = *(const u32x4*)(vfirst + (tokb + tt) * 512 + 64 * h + 8 * cg);
    const int lrw = c32 < 9 ? c32 : 0; const int tprev = (int)t0 - 1 + lrw; const bf16_t* lrow = p + ((size_t)b * TT + (tprev < 0 ? 0 : tprev)) * NP + C_RWWD + 8 * hh;
    const int lr = c32 < 8 ? c32 : 0; const bf16_t* vlb = (const bf16_t*)(P.ws + WS_VL);
#pragma unroll
    for (int ks = 0; ks < 2; ++ks) {
        R.wd[ks] = *(const u32x4*)(lrow + 16 * ks); R.ad[ks] = *(const u32x4*)(lrow + 32 + 16 * ks);
        R.vlp[ks] = *(const u32x4*)(vlb + (tokb + lr) * 32 + 16 * ks + 8 * hh);
    }
}
__device__ __forceinline__ bf16x8 shift_pack(const u32x4 c, const u32x4 q, const LAS float* mu8, const float zprev, const float valid, const bool do_tanh) {
    const f32x4 m0 = *(const LAS f32x4*)mu8, m1 = *(const LAS f32x4*)(mu8 + 4); u32x4 w;
#pragma unroll
    for (int j = 0; j < 4; ++j) {
        const float c0 = blo(c[j]), c1 = bhi(c[j]), q0 = blo(q[j]) * zprev, q1 = bhi(q[j]) * zprev;
        const float ma = j < 2 ? m0[2 * j] : m1[2 * j - 4], mb = j < 2 ? m0[2 * j + 1] : m1[2 * j - 3];
        float x0 = c0 + (q0 - c0) * ma, x1 = c1 + (q1 - c1) * mb;
        if (do_tanh) { x0 = 1.0f - 2.0f * __builtin_amdgcn_rcpf(1.0f + __expf(2.0f * x0)); x1 = 1.0f - 2.0f * __builtin_amdgcn_rcpf(1.0f + __expf(2.0f * x1)); }
        w[j] = att::cvtpk(x0 * valid, x1 * valid);
    }
    return __builtin_bit_cast(bf16x8, w);
}
__device__ __forceinline__ void ld8(float (&o)[8], const LAS float* p) { const f32x4 a = *(const LAS f32x4*)p, b = *(const LAS f32x4*)(p + 4);
#pragma unroll
    for (int j = 0; j < 4; ++j) { o[j] = a[j]; o[4 + j] = b[j]; } }
__device__ __forceinline__ void st8(LAS float* p, const float (&v)[8]) { *(LAS f32x4*)p = (f32x4){v[0], v[1], v[2], v[3]}; *(LAS f32x4*)(p + 4) = (f32x4){v[4], v[5], v[6], v[7]}; }
__device__ __forceinline__ void unp8(float (&o)[8], const u32x4 w) {
#pragma unroll
    for (int j = 0; j < 4; ++j) { o[2 * j] = blo(w[j]); o[2 * j + 1] = bhi(w[j]); } }
__device__ __forceinline__ void h_prep(const HRaw& R, const Params& P, const int l, const int b, const int h, const int rh, LAS unsigned char* lds, const int hw, const int lane, const int cc) {
    const int hh = lane >> 5, c32 = lane & 31, tt = lane >> 3, cg = lane & 7, t0 = cc * 32 + 8 * hw; const size_t tokb = (size_t)b * TT + t0;
    LAS unsigned char* buf = lds + (cc & 1) * BUF;
    const LAS float* mu = (const LAS float*)(lds + O_MU) - 1536;
    const LAS float* cst = (const LAS float*)(lds + O_CST) + 8 * cg;
    LAS float* dsc = (LAS float*)(lds + O_DSC) + hw * (3 * 8 * 64);
    const float valid = c32 < 8 ? 1.0f : 0.0f; const float zprev = (t0 + (c32 < 8 ? c32 : 0)) > 0 ? 1.0f : 0.0f;
    {
        const LAS unsigned char* tab = lds + O_LORA + (c32 * 32 + 8 * hh) * 2;
#define LORA_ONE(LI, A0, A1) do { \
            _Pragma("unroll") for (int tl = 0; tl < 2; ++tl) { f32x16 acc_; _Pragma("unroll") for (int r = 0; r < 16; ++r) acc_[r] = 0.f; \
                acc_ = MFMA32(A0, *(const LAS bf16x8*)(tab + ((LI) * 64 + 32 * tl) * 64), acc_); acc_ = MFMA32(A1, *(const LAS bf16x8*)(tab + ((LI) * 64 + 32 * tl) * 64 + 32), acc_); \
                _Pragma("unroll") for (int i = 0; i < 4; ++i) dsc[((LI) * 8 + 4 * hh + i) * 64 + c32 + 32 * tl] = acc_[i]; } \
            __builtin_amdgcn_sched_barrier(0); } while (0)
#define SHL1(x) ((unsigned)__builtin_amdgcn_update_dpp(0, (int)(x), 0x101, 0xF, 0xF, true))
        { u32x4 c0, c1;
#pragma unroll
          for (int j = 0; j < 4; ++j) { c0[j] = SHL1(R.wd[0][j]); c1[j] = SHL1(R.wd[1][j]); }
          const bf16x8 A0 = shift_pack(c0, R.wd[0], mu + 1536 + 8 * hh, zprev, valid, true), A1 = shift_pack(c1, R.wd[1], mu + 1536 + 16 + 8 * hh, zprev, valid, true);
          LORA_ONE(0, A0, A1); }
        { u32x4 c0, c1;
#pragma unroll
          for (int j = 0; j < 4; ++j) { c0[j] = SHL1(R.ad[0][j]); c1[j] = SHL1(R.ad[1][j]); }
          const bf16x8 A0 = shift_pack(c0, R.ad[0], mu + 1568 + 8 * hh, zprev, valid, false), A1 = shift_pack(c1, R.ad[1], mu + 1568 + 16 + 8 * hh, zprev, valid, false);
          LORA_ONE(1, A0, A1); }
        if (l) { u32x4 v0 = R.vlp[0], v1 = R.vlp[1];
          if (c32 >= 8) { v0 = (u32x4){0u, 0u, 0u, 0u}; v1 = v0; }
          LORA_ONE(2, __builtin_bit_cast(bf16x8, v0), __builtin_bit_cast(bf16x8, v1)); }
#undef SHL1
#undef LORA_ONE
    }
    LDS_WAIT();
    const float pz = (t0 + tt) > 0 ? 1.0f : 0.0f;
    float rr[8], kx[8], vx[8], t8[8], c8[8];
    { float pv[8]; unp8(rr, R.rc); unp8(pv, R.rp); ld8(c8, cst + 6 * 64);
#pragma unroll
      for (int j = 0; j < 8; ++j) rr[j] += (pv[j] * pz - rr[j]) * c8[j];
      unp8(kx, R.kc); unp8(pv, R.kp); ld8(c8, cst + 7 * 64);
#pragma unroll
      for (int j = 0; j < 8; ++j) kx[j] += (pv[j] * pz - kx[j]) * c8[j];
      unp8(vx, R.vc); unp8(pv, R.vp); ld8(c8, cst + 8 * 64);
#pragma unroll
      for (int j = 0; j < 8; ++j) vx[j] += (pv[j] * pz - vx[j]) * c8[j]; }
    float dec[8], aa[8];
    ld8(t8, dsc + (0 * 8 + tt) * 64 + 8 * cg); ld8(c8, cst + 0 * 64);
#pragma unroll
    for (int j = 0; j < 8; ++j) { const float wp = c8[j] + t8[j];
        dec[j] = __builtin_amdgcn_exp2f(-0.8750387749145392f * __builtin_amdgcn_rcpf(1.0f + __builtin_amdgcn_exp2f(-1.4426950408889634f * wp))); }
    ld8(t8, dsc + (1 * 8 + tt) * 64 + 8 * cg); ld8(c8, cst + 1 * 64);
#pragma unroll
    for (int j = 0; j < 8; ++j) aa[j] = fsig(c8[j] + t8[j]);
    if (l == 0) { if (rh == 0) { u32x4 w;
#pragma unroll
        for (int j = 0; j < 4; ++j) w[j] = pk2(vx[2 * j], vx[2 * j + 1]);
        *(u32x4*)((bf16_t*)(P.ws + WS_VFIRST) + (tokb + tt) * 512 + 64 * h + 8 * cg) = w; } }
    if (l) { float vf8[8]; unp8(vf8, R.vf); ld8(t8, dsc + (2 * 8 + tt) * 64 + 8 * cg); ld8(c8, cst + 2 * 64);
#pragma unroll
      for (int j = 0; j < 8; ++j) vx[j] += (vf8[j] - vx[j]) * fsig(c8[j] + t8[j]); }
    float kk[8], kp[8]; float n2p = 0.f, bop = 0.f;
    ld8(c8, cst + 3 * 64);
#pragma unroll
    for (int j = 0; j < 8; ++j) { kk[j] = kx[j] * c8[j]; n2p += kk[j] * kk[j]; }
    ld8(c8, cst + 4 * 64);
#pragma unroll
    for (int j = 0; j < 8; ++j) kp[j] = kx[j] * (1.f + (aa[j] - 1.f) * c8[j]);
    ld8(c8, cst + 5 * 64);
#pragma unroll
    for (int j = 0; j < 8; ++j) bop += rr[j] * kp[j] * c8[j];
    const float n2 = red8(n2p), bon = red8(bop);
    const float inv = __builtin_amdgcn_rsqf(fmaxf(n2, 1e-24f));
    const int ttc = 8 * hw + tt; LAS float* ob = (LAS float*)buf + ttc * 64 + 8 * cg;
    st8(ob + O_W / 4, dec); st8(ob + O_KP / 4, kp); st8(ob + O_R / 4, rr); st8(ob + O_V / 4, vx);
#pragma unroll
    for (int j = 0; j < 8; ++j) { kk[j] *= inv; aa[j] *= kk[j]; kk[j] = -kk[j]; }
    st8(ob + O_NKK / 4, kk); st8(ob + O_KKA / 4, aa);
    if (cg == 0) *(LAS float*)(lds + O_BON + ((cc & 1) * 32 + ttc) * 4) = bon;
}

__device__ __forceinline__ void unit(const Params& P, int l, int b, int h, int rh, LAS unsigned char* lds, const int wid) {
    const int tid = PHASE_TID(wid);
    const int lane = tid & 63;
    constexpr int NCH = TT / 32;
    if (wid < 4) {
        f32x2 S[2];
#pragma unroll
        for (int j = 0; j < 2; ++j) S[j] = (f32x2){0.f, 0.f};
        const int srow = 4 * wid + (lane >> 4), kq = lane & 15, vrow = 16 * rh + srow;
        __builtin_amdgcn_s_setprio(3);
        LDS_BARRIER();
        LDS_BARRIER();
#pragma unroll 1
        for (int c = 0; c < NCH; ++c) {
            LAS unsigned char* bk = lds + (c & 1) * BUF + 16 * kq; LAS unsigned char* bv = lds + (c & 1) * BUF + O_V + 4 * vrow; LAS float* by = (LAS float*)(lds + O_YB + (c & 1) * 2048) + srow;
            Ops A, B;
            load_ops(A, bk, bv, 0);
            f32x4 rp = A.r;
#pragma unroll
            for (int tt = 0; tt < 32; tt += 2) {
                load_ops(B, bk, bv, tt + 1);
                step(A, rp, S, by, tt); rp = A.r;
                if (tt + 2 < 32) load_ops(A, bk, bv, tt + 2);
                step(B, rp, S, by, tt + 1); rp = B.r;
            }
            { f32x2 u = S[0] * V2LO(rp); u = S[1] * V2HI(rp) + u; const float yv = red16(u.x + u.y); by[31 * 16] = yv; }
            LDS_BARRIER();
        }
        __builtin_amdgcn_s_setprio(0);
    } else {
        const int hw = wid - 4;
        bf16_t* y = (bf16_t*)(P.ws + WS_XB); bf16_t* bvb = (bf16_t*)(P.ws + WS_BV);
        { LAS bf16_t* tab = (LAS bf16_t*)(lds + O_LORA);
          for (int e = hw * 64 + lane; e < 64 * 32; e += 256) { const int cc_ = e >> 5, j = e & 31;
              tab[e] = (bf16_t)f2bf(P.in[7][(l * 32 + j) * 512 + 64 * h + cc_]); tab[2048 + e] = (bf16_t)f2bf(P.in[9][(l * 32 + j) * 512 + 64 * h + cc_]);
              tab[4096 + e] = (bf16_t)f2bf(l ? P.in[12][j * 512 + 64 * h + cc_] : 0.f); }
          const int ch = 64 * h + lane; const float* mu = P.in[5] + l * 1600; LAS float* cst = (LAS float*)(lds + O_CST);
          if (hw == 0) { ((LAS float*)(lds + O_MU))[lane] = mu[1536 + lane]; cst[0 * 64 + lane] = P.in[6][l * 512 + ch]; cst[1 * 64 + lane] = P.in[8][l * 512 + ch]; cst[2 * 64 + lane] = l ? P.in[10][ch] : 0.f; }
          if (hw == 1) { cst[3 * 64 + lane] = P.in[13][l * 512 + ch]; cst[4 * 64 + lane] = P.in[14][l * 512 + ch]; cst[5 * 64 + lane] = P.in[15][l * 512 + ch]; }
          if (hw == 2) { cst[6 * 64 + lane] = mu[ch]; cst[7 * 64 + lane] = mu[512 + ch]; cst[8 * 64 + lane] = mu[1024 + ch]; } }
        HRaw RA, RB;
#define WKV_OUT(cc) do { if (lane < 16) { const LAS float* buf_ = (const LAS float*)(lds + ((cc) & 1) * BUF); const LAS float* yb_ = (const LAS float*)(lds + O_YB + ((cc) & 1) * 2048); \
            const int tt_ = 8 * hw + (lane >> 1), r0_ = 8 * (lane & 1); float y8_[8], v8_[8]; ld8(y8_, yb_ + tt_ * 16 + r0_); ld8(v8_, buf_ + O_V / 4 + tt_ * 64 + 16 * rh + r0_); \
            const float bo_ = *(const LAS float*)(lds + O_BON + (((cc) & 1) * 32 + tt_) * 4); const size_t tok_ = (size_t)b * TT + (cc) * 32 + tt_; u32x4 wy_, wb_; \
            _Pragma("unroll") for (int j_ = 0; j_ < 4; ++j_) { wy_[j_] = pk2(y8_[2 * j_], y8_[2 * j_ + 1]); wb_[j_] = pk2(bo_ * v8_[2 * j_], bo_ * v8_[2 * j_ + 1]); } \
            *(u32x4*)(y + tok_ * DM + Y_RW + 64 * h + 16 * rh + r0_) = wy_; *(u32x4*)(bvb + tok_ * 512 + 64 * h + 16 * rh + r0_) = wb_; } } while (0)
        h_load(RA, P, b, h, hw, lane, 0);
        h_load(RB, P, b, h, hw, lane, 1);
        LDS_BARRIER();
        h_prep(RA, P, l, b, h, rh, lds, hw, lane, 0);
        LDS_BARRIER();
#pragma unroll 1
        for (int c = 0; c < NCH; c += 2) {
            if (c > 0) WKV_OUT(c - 1);
            if (c + 2 < NCH) h_load(RA, P, b, h, hw, lane, c + 2);
            h_prep(RB, P, l, b, h, rh, lds, hw, lane, c + 1);
            LDS_BARRIER();
            WKV_OUT(c);
            if (c + 3 < NCH) h_load(RB, P, b, h, hw, lane, c + 3);
            if (c + 2 < NCH) h_prep(RA, P, l, b, h, rh, lds, hw, lane, c + 2);
            LDS_BARRIER();
        }
        WKV_OUT(NCH - 1);
#undef WKV_OUT
    }
}

__device__ __forceinline__ void post_phase(const Params& P, int l, const int wid) {
    const int tid = PHASE_TID(wid);
    const int lane = tid & 63, nw = blockDim.x >> 6;
    const bf16_t* p = (const bf16_t*)(P.ws + WS_P); bf16_t* y = (bf16_t*)(P.ws + WS_XB); const bf16_t* bvb = (const bf16_t*)(P.ws + WS_BV);
    const float beta = P.in[4][l * 4 + 0];
    float lw[8], lb[8];
#pragma unroll
    for (int j = 0; j < 8; ++j) { lw[j] = P.in[16][l * 512 + 8 * lane + j]; lb[j] = P.in[17][l * 512 + 8 * lane + j]; }
    for (int tok = blockIdx.x * nw + wid; tok < NTOK; tok += gridDim.x * nw) {
        u32x4* yp = (u32x4*)(y + (size_t)tok * DM + Y_RW + 8 * lane);
        const u32x4 yy = *yp, bb = *(const u32x4*)(bvb + (size_t)tok * 512 + 8 * lane), zz = *(const u32x4*)(p + (size_t)tok * NP + C_Z + Y_RW + 8 * lane);
        float v[8]; float sm = 0.f;
#pragma unroll
        for (int j = 0; j < 4; ++j) { v[2 * j] = blo(yy[j]); v[2 * j + 1] = bhi(yy[j]); sm += v[2 * j] + v[2 * j + 1]; }
        const float mean = red8(sm) * (1.0f / 64.f); float sq = 0.f;
#pragma unroll
        for (int j = 0; j < 8; ++j) { v[j] -= mean; sq += v[j] * v[j]; }
        const float rs = rsqrtf(red8(sq) * (1.0f / 64.f) + 64e-5f);
        u32x4 o;
#pragma unroll
        for (int j = 0; j < 4; ++j) { const float z0 = blo(zz[j]), z1 = bhi(zz[j]);
            const float o0 = v[2 * j] * rs * lw[2 * j] + lb[2 * j] + blo(bb[j]), o1 = v[2 * j + 1] * rs * lw[2 * j + 1] + lb[2 * j + 1] + bhi(bb[j]);
            o[j] = pk2(beta * o0 * (z0 / (1.0f + __expf(-z0))), beta * o1 * (z1 / (1.0f + __expf(-z1)))); }
        *yp = o;
    }
}
}

namespace mls {
using att::s16x4; using att::vtr; using att::cvtpk;
constexpr int QP = 272, VP = 320;
constexpr int L_Q = 0, L_K = 17408, L_KW = 34816, L_V = 55296, L_U = 75776, L_CJ = L_U + 256, L_IW = L_CJ + 256, L_FL = L_IW + 256, L_WK = L_FL + 256, L_QN = L_WK + 256,
              L_N = L_QN + 256  , L_SS = L_N + 1024  , L_SC = L_SS + 1024  , L_CW = L_SC + 256  , L_NG = L_CW + 5 * 1024  ;
__device__ __forceinline__ bf16x8 pack8(const f32x16& x, const int s2) { u32x4 w;
#pragma unroll
    for (int j = 0; j < 4; ++j) w[j] = cvtpk(x[8 * s2 + 2 * j], x[8 * s2 + 2 * j + 1]);
    return __builtin_bit_cast(bf16x8, w); }

__device__ __forceinline__ void unit(const Params& P, int l, int b, int h, LAS unsigned char* lds, const int wid) {
    const int tid = PHASE_TID(wid);
    const int lane = tid & 63, r32 = lane & 31, hh = lane >> 5, g16 = lane >> 4, i16 = lane & 15;
    const bf16_t* p = (const bf16_t*)(P.ws + WS_P); bf16_t* y = (bf16_t*)(P.ws + WS_XB); const float* gates = (const float*)(P.ws + WS_GATES);
    const int cgq = tid & 31, tq = tid >> 5, cisk = cgq >> 4, ccol = (cisk ? C_MLK : C_MLQ) + 128 * h + 8 * (cgq & 15);
    const float cscale = cisk ? 0.08838834764831845f : 1.0f;
    if (tid < 256) { const int cidx = ((tid >> 7) ? 512 : 0) + 128 * h + (tid & 127);
#pragma unroll
        for (int j = 0; j < 4; ++j) ((LAS float*)(lds + L_CW))[j * 256 + tid] = P.in[18][(l * 4 + j) * 1024 + cidx];
        ((LAS float*)(lds + L_CW))[4 * 256 + tid] = P.in[19][l * 1024 + cidx]; }
    if (tid < 128) ((LAS float*)(lds + L_NG))[tid] = P.in[22][l * 512 + 128 * h + tid];
    if (tid == 0) { LAS float* sc_ = (LAS float*)(lds + L_SC); sc_[2] = P.in[20][l * 4 + h]; sc_[3] = P.in[21][l * 4 + h]; sc_[4] = P.in[4][l * 4 + 1]; }
    const int vb = wid & 3, jb = wid >> 2, jl = 32 * jb + r32;
    f32x16 ct[4];
#pragma unroll
    for (int kb = 0; kb < 4; ++kb)
#pragma unroll
        for (int r = 0; r < 16; ++r) ct[kb][r] = 0.f;
    float m_prev = 0.f;
    if (tid < 256) ((LAS float*)(lds + L_N))[tid] = 0.f;
    __syncthreads();
    const int trow = (i16 >> 2), tcol = (16 * (g16 & 1) + 4 * (i16 & 3)) * 2;
    u32x4 cxr[7]; u32x4 vreg[2]; float g_ig, g_fx; u32x2 oo[4], zz[4];
#define MLS_LOAD(c_) do { const size_t tk_ = (size_t)b * TT + (size_t)(c_) * 64; \
        const bf16_t* src_ = p + (tk_ + 4 * tq) * NP + ccol; const bool hp_ = ((c_) > 0) || (tq > 0); \
        _Pragma("unroll") for (int i_ = 0; i_ < 7; ++i_) cxr[i_] = *(const u32x4*)(src_ + (long)((hp_ || i_ >= 3) ? (i_ - 3) : 0) * NP); \
        _Pragma("unroll") for (int i_ = 0; i_ < 2; ++i_) { const int cc_ = tid + 512 * i_; vreg[i_] = *(const u32x4*)(p + (tk_ + (cc_ >> 4)) * NP + C_MLV + 128 * h + (cc_ & 15) * 8); } \
        g_ig = gates[(tk_ + lane) * 8 + h]; g_fx = gates[(tk_ + lane) * 8 + 4 + h]; } while (0)
    MLS_LOAD(0);
#pragma unroll 1
    for (int c = 0; c < TT / 64; ++c) {
        const size_t tok0 = (size_t)b * TT + c * 64;
        LAS float* Nold = (LAS float*)(lds + L_N) + 128 * (c & 1); LAS float* Nnew = (LAS float*)(lds + L_N) + 128 * ((c + 1) & 1);
        if (wid == 0) {
            const float ig = g_ig + ((const LAS float*)(lds + L_SC))[2]; const float fx = g_fx + ((const LAS float*)(lds + L_SC))[3]; const float lf = -0.6931471805599453f * __builtin_amdgcn_logf(1.0f + __builtin_amdgcn_exp2f(-1.4426950408889634f * fx));
            const float bs = scan_sum64(lf);
            const float u = ig - bs; const float pm = scan_max64(u);
            const float mx = fmaxf(m_prev, pm), mj = bs + mx, cj = -mx;
            const float b_last = lane63(bs), pm_last = lane63(pm), m_new = b_last + fmaxf(m_prev, pm_last);
            ((LAS float*)(lds + L_U))[lane] = u; ((LAS float*)(lds + L_CJ))[lane] = cj; ((LAS float*)(lds + L_IW))[lane] = __expf(cj + m_prev);
            ((LAS float*)(lds + L_FL))[lane] = __expf(-mj); ((LAS float*)(lds + L_WK))[lane] = __expf(b_last + u - m_new);
            if (lane == 0) { ((LAS float*)(lds + L_SC))[0] = __expf(b_last + m_prev - m_new); ((LAS float*)(lds + L_SC))[1] = m_new; }
        }
#pragma unroll
        for (int i = 0; i < 2; ++i) { const int cc = tid + 512 * i; *(LAS u32x4*)(lds + L_V + (cc >> 4) * VP + (cc & 15) * 16) = vreg[i]; }
        {
            const float pz = ((c > 0) || (tq > 0)) ? 1.0f : 0.0f;
            const LAS float* cwt = (const LAS float*)(lds + L_CW) + 8 * cgq;
            float w0[8], w1[8], w2[8], w3[8], bb[8];
            wkv::ld8(w0, cwt); wkv::ld8(w1, cwt + 256); wkv::ld8(w2, cwt + 512); wkv::ld8(w3, cwt + 768); wkv::ld8(bb, cwt + 1024);
            float xa[8], xb_[8], xc[8], xd[8];
            wkv::unp8(xa, cxr[0]); wkv::unp8(xb_, cxr[1]); wkv::unp8(xc, cxr[2]);
#pragma unroll
            for (int j = 0; j < 8; ++j) { xa[j] *= pz; xb_[j] *= pz; xc[j] *= pz; }
            LAS unsigned char* dst = lds + (cisk ? L_K : L_Q) + (4 * tq) * QP + 16 * (cgq & 15);
#pragma unroll
            for (int i = 0; i < 4; ++i) {
                wkv::unp8(xd, cxr[3 + i]);
                u32x4 o;
#pragma unroll
                for (int j2 = 0; j2 < 4; ++j2) { float r2[2];
#pragma unroll
                    for (int e = 0; e < 2; ++e) { const int j = 2 * j2 + e; const float cv = bb[j] + xa[j] * w0[j] + xb_[j] * w1[j] + xc[j] * w2[j] + xd[j] * w3[j];
                        r2[e] = cv * __builtin_amdgcn_rcpf(1.0f + __expf(-cv)) * cscale; }
                    o[j2] = pk2(r2[0], r2[1]); }
                *(LAS u32x4*)(dst + i * QP) = o;
#pragma unroll
                for (int j = 0; j < 8; ++j) { xa[j] = xb_[j]; xb_[j] = xc[j]; xc[j] = xd[j]; }
            }
        }
        {
            const size_t tok = tok0 + jl; const bf16_t* orow = p + tok * NP + C_MLO + 128 * h; const bf16_t* zrow = p + tok * NP + C_Z + Y_ML + 128 * h;
#pragma unroll
            for (int g = 0; g < 4; ++g) { const int v = 32 * vb + 8 * g + 4 * hh; oo[g] = *(const u32x2*)(orow + v); zz[g] = *(const u32x2*)(zrow + v); }
        }
        LDS_BARRIER();
        m_prev = ((const LAS float*)(lds + L_SC))[1];
        {
            const int s_ = tid >> 3, k0 = (tid & 7) * 16; const float wk = ((const LAS float*)(lds + L_WK))[s_];
            float qn = 0.f;
#pragma unroll
            for (int q = 0; q < 2; ++q) { const u32x4 kv = *(const LAS u32x4*)(lds + L_K + s_ * QP + (k0 + 8 * q) * 2); u32x4 o;
#pragma unroll
                for (int j = 0; j < 4; ++j) o[j] = pk2(__uint_as_float(kv[j] << 16) * wk, __uint_as_float(kv[j] & 0xffff0000u) * wk);
                *(LAS u32x4*)(lds + L_KW + s_ * VP + (k0 + 8 * q) * 2) = o;
                const u32x4 qv = *(const LAS u32x4*)(lds + L_Q + s_ * QP + (k0 + 8 * q) * 2); const f32x4 n0 = *(const LAS f32x4*)(Nold + k0 + 8 * q), n1 = *(const LAS f32x4*)(Nold + k0 + 8 * q + 4);
                qn += __uint_as_float(qv[0] << 16) * n0[0] + __uint_as_float(qv[0] & 0xffff0000u) * n0[1] + __uint_as_float(qv[1] << 16) * n0[2] + __uint_as_float(qv[1] & 0xffff0000u) * n0[3]
                    + __uint_as_float(qv[2] << 16) * n1[0] + __uint_as_float(qv[2] & 0xffff0000u) * n1[1] + __uint_as_float(qv[3] << 16) * n1[2] + __uint_as_float(qv[3] & 0xffff0000u) * n1[3]; }
            qn = sum8(qn);
            if ((tid & 7) == 0) ((LAS float*)(lds + L_QN))[s_] = qn;
            { const int k = tid >> 2, sq_ = (tid & 3) * 16; float acc = 0.f;
#pragma unroll
              for (int s2 = 0; s2 < 16; ++s2) acc += ((const LAS float*)(lds + L_WK))[sq_ + s2] * bf2f(((const LAS bf16_t*)(lds + L_K + (sq_ + s2) * QP))[k]);
              acc = sum4(acc);
              if ((tid & 3) == 0) Nnew[k] = ((const LAS float*)(lds + L_SC))[0] * Nold[k] + acc; }
        }
        if (c + 1 < TT / 64) MLS_LOAD(c + 1);
        LDS_BARRIER();
        unsigned gf[8];
#pragma unroll
        for (int g = 0; g < 4; ++g) {
            const float o0 = blo(oo[g].x), o1 = bhi(oo[g].x), o2 = blo(oo[g].y), o3 = bhi(oo[g].y), z0 = blo(zz[g].x), z1 = bhi(zz[g].x), z2 = blo(zz[g].y), z3 = bhi(zz[g].y);
#define GF_(o_, z_) ((z_) * __builtin_amdgcn_rcpf((1.0f + __expf(-(o_))) * (1.0f + __expf(-(z_)))))
            gf[2 * g] = pk2(GF_(o0, z0), GF_(o1, z1)); gf[2 * g + 1] = pk2(GF_(o2, z2), GF_(o3, z3));
#undef GF_
        }
        f32x16 num; float dsum = 0.f;
#pragma unroll
        for (int r = 0; r < 16; ++r) num[r] = 0.f;
        const float cj = ((const LAS float*)(lds + L_CJ))[jl];
#pragma unroll
        for (int sb = 0; sb < 2; ++sb) {
            if (sb <= jb) {
                f32x16 s;
#pragma unroll
                for (int r = 0; r < 16; ++r) s[r] = 0.f;
                {
                    const LAS unsigned char* kp_ = lds + L_K + (32 * sb + r32) * QP + 16 * hh; const LAS unsigned char* qp_ = lds + L_Q + jl * QP + 16 * hh;
                    bf16x8 ak_[3], bq_[3];
#pragma unroll
                    for (int ks = 0; ks < 3; ++ks) { ak_[ks] = *(const LAS bf16x8*)(kp_ + 32 * ks); bq_[ks] = *(const LAS bf16x8*)(qp_ + 32 * ks); }
#pragma unroll
                    for (int ks = 0; ks < 8; ++ks) {
                        s = MFMA32(ak_[ks % 3], bq_[ks % 3], s);
                        if (ks + 3 < 8) { ak_[ks % 3] = *(const LAS bf16x8*)(kp_ + 32 * (ks + 3)); bq_[ks % 3] = *(const LAS bf16x8*)(qp_ + 32 * (ks + 3)); }
                    }
                }
                LAS unsigned char* vbase = lds + L_V + (trow + 4 * hh + 32 * sb) * VP + 64 * vb + tcol;
                const s16x4 lo0 = vtr(vbase), hi0 = vtr(vbase + 8 * VP), lo1 = vtr(vbase + 16 * VP), hi1 = vtr(vbase + 24 * VP);
#pragma unroll
                for (int g = 0; g < 4; ++g) { const f32x4 u4 = *(const LAS f32x4*)(lds + L_U + (32 * sb + 8 * g + 4 * hh) * 4);
#pragma unroll
                    for (int i = 0; i < 4; ++i) { const int srow = 32 * sb + 8 * g + 4 * hh + i; const float w = srow <= jl ? __expf(cj + u4[i]) : 0.f; s[4 * g + i] *= w; dsum += s[4 * g + i]; } }
                const bf16x8 pf0 = pack8(s, 0), pf1 = pack8(s, 1);
                num = MFMA32(__builtin_shufflevector(lo0, hi0, 0, 1, 2, 3, 4, 5, 6, 7), pf0, num);
                num = MFMA32(__builtin_shufflevector(lo1, hi1, 0, 1, 2, 3, 4, 5, 6, 7), pf1, num);
            }
        }
        dsum = xor32_sum(dsum);
        f32x16 it;
#pragma unroll
        for (int r = 0; r < 16; ++r) it[r] = 0.f;
        {
            const LAS unsigned char* qb_ = lds + L_Q + jl * QP + 8 * hh;
            bf16x8 qq_[3];
#pragma unroll
            for (int i = 0; i < 3; ++i) { const s16x4 lo = *(const LAS s16x4*)(qb_ + 32 * i), hi = *(const LAS s16x4*)(qb_ + 32 * i + 16); qq_[i] = __builtin_shufflevector(lo, hi, 0, 1, 2, 3, 4, 5, 6, 7); }
#pragma unroll
            for (int i = 0; i < 8; ++i) {
                it = MFMA32(pack8(ct[i >> 1], i & 1), qq_[i % 3], it);
                if (i + 3 < 8) { const s16x4 lo = *(const LAS s16x4*)(qb_ + 32 * (i + 3)), hi = *(const LAS s16x4*)(qb_ + 32 * (i + 3) + 16); qq_[i % 3] = __builtin_shufflevector(lo, hi, 0, 1, 2, 3, 4, 5, 6, 7); }
            }
        }
        const float iw = ((const LAS float*)(lds + L_IW))[jl], fl = ((const LAS float*)(lds + L_FL))[jl], qn = ((const LAS float*)(lds + L_QN))[jl];
        const float den = dsum + iw * qn; const float dd = 1.0f / fmaxf(fabsf(den), fl);
        float ss = 0.f;
#pragma unroll
        for (int r = 0; r < 16; ++r) { num[r] = (num[r] + iw * it[r]) * dd; ss += num[r] * num[r]; }
        ss = xor32_sum(ss);
        if (hh == 0) ((LAS float*)(lds + L_SS))[vb * 64 + jl] = ss;
        {
            const float a_old = ((const LAS float*)(lds + L_SC))[0];
            LAS unsigned char* ka0 = lds + L_KW + (trow + 8 * hh) * VP + tcol; LAS unsigned char* va0 = lds + L_V + (trow + 8 * hh) * VP + 64 * vb + tcol;
            bf16x8 vfr_[4], kfr_[2];
#pragma unroll
            for (int s4 = 0; s4 < 4; ++s4) { const s16x4 lo = vtr(va0 + 16 * s4 * VP), hi = vtr(va0 + (16 * s4 + 4) * VP); vfr_[s4] = __builtin_shufflevector(lo, hi, 0, 1, 2, 3, 4, 5, 6, 7); }
#pragma unroll
            for (int i = 0; i < 2; ++i) { const s16x4 lo = vtr(ka0 + 16 * (i & 3) * VP + 64 * (i >> 2)), hi = vtr(ka0 + (16 * (i & 3) + 4) * VP + 64 * (i >> 2)); kfr_[i] = __builtin_shufflevector(lo, hi, 0, 1, 2, 3, 4, 5, 6, 7); }
#pragma unroll
            for (int kb = 0; kb < 4; ++kb) {
#pragma unroll
                for (int r = 0; r < 16; ++r) ct[kb][r] *= a_old;
#pragma unroll
                for (int s4 = 0; s4 < 4; ++s4) { const int i = 4 * kb + s4;
                    ct[kb] = MFMA32(kfr_[i & 1], vfr_[s4], ct[kb]);
                    if (i + 2 < 16) { const int n = i + 2; const s16x4 lo = vtr(ka0 + 16 * (n & 3) * VP + 64 * (n >> 2)), hi = vtr(ka0 + (16 * (n & 3) + 4) * VP + 64 * (n >> 2)); kfr_[i & 1] = __builtin_shufflevector(lo, hi, 0, 1, 2, 3, 4, 5, 6, 7); }
                }
            }
        }
        LDS_BARRIER();
        {
            const LAS float* SS = (const LAS float*)(lds + L_SS);
            const float tot = SS[jl] + SS[64 + jl] + SS[128 + jl] + SS[192 + jl];
            const float rs = rsqrtf(tot * (1.0f / 128.f) + 1e-6f) * ((const LAS float*)(lds + L_SC))[4];
            const size_t tok = tok0 + jl;
            bf16_t* yrow = y + tok * DM + Y_ML + 128 * h; const LAS float* ng = (const LAS float*)(lds + L_NG);
#pragma unroll
            for (int g = 0; g < 4; ++g) { const int v = 32 * vb + 8 * g + 4 * hh; const f32x4 gg = *(const LAS f32x4*)(ng + v);
                const float gv[4] = {blo(gf[2 * g]), bhi(gf[2 * g]), blo(gf[2 * g + 1]), bhi(gf[2 * g + 1])};
                float res[4];
#pragma unroll
                for (int i = 0; i < 4; ++i) res[i] = rs * gg[i] * num[4 * g + i] * gv[i];
                u32x2 w; w.x = pk2(res[0], res[1]); w.y = pk2(res[2], res[3]); *(u32x2*)(yrow + v) = w; }
        }
    }
#undef MLS_LOAD
}
}

#define XB_TMO      128
#define XB_XCNT(j)  (256  + 64 * (j))
#define XB_XSUB(j)  (1280 + 64 * (j))
#define XB_XGEN(j)  (2304 + 64 * (j))
#define XB_TOP      3328
#define XB_TOPGEN   3392
#define XCD_BAR_WORDS 3456
#define XB_SPIN_CAP (1u << 22)
__device__ __forceinline__ unsigned xb_ld(unsigned* p)              { return __hip_atomic_load(p, __ATOMIC_RELAXED, __HIP_MEMORY_SCOPE_AGENT); }
__device__ __forceinline__ unsigned xb_add(unsigned* p, unsigned v) { return __hip_atomic_fetch_add(p, v, __ATOMIC_RELAXED, __HIP_MEMORY_SCOPE_AGENT); }
__device__ __forceinline__ unsigned xb_xcc_id() { return (unsigned)__builtin_amdgcn_s_getreg((3 << 11) | 20) & 0xFu; }
#define XB_SPIN(cond, bar) do { unsigned _sp = 0; while (cond) { __builtin_amdgcn_s_sleep(1); \
    if ((++_sp & 255u) == 0u) { if (xb_ld(&(bar)[XB_TMO])) break; if (_sp > XB_SPIN_CAP) { atomicAdd(&(bar)[XB_TMO], 1u); break; } } } } while (0)
__device__ __forceinline__ void xcd_barrier_complete(unsigned* bar, unsigned x, unsigned& nloc, unsigned& nx, const unsigned G) {
    unsigned sum, cnt, mine, sp = 0u;
    for (;;) {
        sum = 0u; cnt = 0u; mine = 0u;
#pragma unroll
        for (unsigned j = 0; j < 16; ++j) { const unsigned c = xb_ld(&bar[XB_XCNT(j)]); sum += c; cnt += (c > 0u) ? 1u : 0u; mine = (j == x) ? c : mine; }
        if (sum == G) break;
        __builtin_amdgcn_s_sleep(1);
        if ((++sp & 255u) == 0u) { if (xb_ld(&bar[XB_TMO])) break; if (sp > XB_SPIN_CAP) { atomicAdd(&bar[XB_TMO], 1u); break; } }
    }
    nloc = mine > 0u ? mine : 1u; nx = cnt > 0u ? cnt : 1u;
}
__device__ __forceinline__ void xcd_barrier(unsigned* bar, volatile LAS unsigned* st, const int wid, const unsigned nblocks) {
    asm volatile("s_waitcnt vmcnt(0)" ::: "memory");
    __syncthreads();
    if (wid == 0 && lane_id_opaque() == 0) {
        __builtin_amdgcn_s_waitcnt(0);
        const unsigned x = xb_xcc_id();
        unsigned nloc = st[0], nx = st[1];
        if (nloc == 0u) { xcd_barrier_complete(bar, x, nloc, nx, nblocks); st[0] = nloc; st[1] = nx; }
        const unsigned old = xb_add(&bar[XB_XSUB(x)], 1u);
        const unsigned gen = old / nloc;
        if (old + 1u == (gen + 1u) * nloc) {
            __builtin_amdgcn_fence(__ATOMIC_RELEASE, "agent");
            asm volatile("s_waitcnt vmcnt(0)" ::: "memory");
            const unsigned og = xb_add(&bar[XB_TOP], 1u);
            const unsigned tg = og / nx;
            if (og + 1u == (tg + 1u) * nx) xb_add(&bar[XB_TOPGEN], 1u);
            else XB_SPIN(xb_ld(&bar[XB_TOPGEN]) == tg, bar);
            __builtin_amdgcn_fence(__ATOMIC_ACQUIRE, "agent");
            xb_add(&bar[XB_XGEN(x)], 1u);
            asm volatile("s_waitcnt vmcnt(0)" ::: "memory");
        } else {
            XB_SPIN(xb_ld(&bar[XB_XGEN(x)]) == gen, bar);
            __builtin_amdgcn_fence(__ATOMIC_ACQUIRE, "agent");
            asm volatile("s_waitcnt vmcnt(0)" ::: "memory");
        }
    }
    __syncthreads();
}

__device__ __forceinline__ void flag_set(unsigned* f, const int wid) { if (wid == 0 && lane_id_opaque() == 0) __hip_atomic_store(f, 1u, __ATOMIC_RELAXED, __HIP_MEMORY_SCOPE_AGENT); }
__device__ __forceinline__ void flag_wait(unsigned* f, const int wid) {
    if (wid == 0 && lane_id_opaque() == 0) {
        unsigned sp = 0; while (__hip_atomic_load(f, __ATOMIC_RELAXED, __HIP_MEMORY_SCOPE_AGENT) == 0u && ++sp < (1u << 24)) __builtin_amdgcn_s_sleep(8);
        __builtin_amdgcn_fence(__ATOMIC_ACQUIRE, "agent");
        asm volatile("s_waitcnt vmcnt(0)" ::: "memory");
    }
    __syncthreads();
}

__global__ void __launch_bounds__(512, 2) k_mega(Params P) {
    extern __shared__ __attribute__((aligned(16))) unsigned char dynlds[];
    LAS unsigned char* lds = (LAS unsigned char*)dynlds;
    cg::grid_group grid = cg::this_grid();
    unsigned char* ws = P.ws;
    const int wid0 = __builtin_amdgcn_readfirstlane((int)(threadIdx.x >> 6));
    unsigned* xbar = (unsigned*)(ws + WS_CTL) + 16384;
    unsigned* xbar2 = (unsigned*)(ws + WS_CTL) + 16384 + 4096;
    unsigned* flags = (unsigned*)(ws + WS_CTL) + 64 * 48;
    volatile LAS unsigned* xst = (volatile LAS unsigned*)(lds + 147456 - 16);
    constexpr int NSCAN = 144;
    if (threadIdx.x < 4) xst[threadIdx.x] = 0u;
    __syncthreads();
    if (threadIdx.x == 0) { (void)xb_add(&xbar[XB_XCNT(xb_xcc_id())], 1u); if ((int)blockIdx.x >= NSCAN) (void)xb_add(&xbar2[XB_XCNT(xb_xcc_id())], 1u); }
#define GRID_BAR() do { int w_ = wid0; OPAQUE_S(w_); xcd_barrier(xbar, xst, w_, gridDim.x); } while (0)
#define GROUP_BAR() do { int w_ = wid0; OPAQUE_S(w_); xcd_barrier(xbar2, xst + 2, w_, gridDim.x - NSCAN); } while (0)
#define PHASE_IDS int wid = wid0, bid = (int)blockIdx.x, G = (int)gridDim.x; OPAQUE_S(wid); OPAQUE_S(bid); OPAQUE_S(G)
    { PHASE_IDS; (void)bid; (void)G; prologue_phase(P, lds, wid); }
    grid.sync();
#pragma unroll 1
    for (int l = 0; l < 2; ++l) {
        { PHASE_IDS; (void)bid; (void)G; p1_phase(P, l, lds, wid); }
        GRID_BAR();
        {
            PHASE_IDS;
            pg8::Gemm g{(const bf16_t*)(ws + WS_XB), (const bf16_t*)(ws + WS_WIN(l)), NTOK, NP, DM, DM};
            pg8::EpiRowScaleBf16 E{(bf16_t*)(ws + WS_P), (const float*)(ws + WS_RSTD), NP, 0};
            pg8::StaticOrder S; S.init(NTOK, NP, G, bid);
            pg8::gemm_phase<pg8::EpiRowScaleBf16, pg8::StaticOrder, true>(lds, g, S, E, wid);
        }
        GRID_BAR();
        { int bsel = (int)blockIdx.x; OPAQUE_S(bsel);
          if (bsel < NSCAN) {
              { PHASE_IDS; (void)G;
                if (bid < 128) { if (l == 1) flag_wait(flags + 64 * 0, wid); wkv::unit(P, l, bid >> 5, (bid >> 2) & 7, bid & 3, lds, wid); }
                else mls::unit(P, l, (bid - 128) >> 2, (bid - 128) & 3, lds, wid); }
              { int w_ = wid0; OPAQUE_S(w_); __syncthreads(); flag_wait(flags + 64 * (1 + l), w_); }
          } else {
              if (l == 1) { { PHASE_IDS; vl_phase(P, wid, bid - NSCAN, G - NSCAN); } GROUP_BAR(); { int w_ = wid0, b_ = (int)blockIdx.x; OPAQUE_S(w_); OPAQUE_S(b_); if (b_ == NSCAN) flag_set(flags + 64 * 0, w_); } }
              { PHASE_IDS;
                pg8::Gemm g{(const bf16_t*)(ws + WS_P) + C_QLAT, (const bf16_t*)(ws + WS_WQ(l)), NTOK, 768, 384, NP};
                pg8::EpiRowScaleBf16 E{(bf16_t*)(ws + WS_QRAW), nullptr, 768, 0};
                pg8::StaticOrder S; S.init(NTOK, 768, G - NSCAN, bid - NSCAN);
                pg8::gemm_phase<pg8::EpiRowScaleBf16, pg8::StaticOrder, true>(lds, g, S, E, wid); }
              { PHASE_IDS;
                pg8::Gemm g{(const bf16_t*)(ws + WS_P) + C_KVLAT, (const bf16_t*)(ws + WS_WKV(l)), NTOK, 1024, 256, NP};
                pg8::EpiRowScaleBf16 E{(bf16_t*)(ws + WS_KVRAW), nullptr, 1024, 0};
                pg8::StaticOrder S; S.init(NTOK, 1024, G - NSCAN, bid - NSCAN);
                pg8::gemm_phase<pg8::EpiRowScaleBf16, pg8::StaticOrder, true>(lds, g, S, E, wid); }
              { PHASE_IDS; da_prep_phase(P, l, wid, bid - NSCAN, G - NSCAN); }
              GROUP_BAR();
              { PHASE_IDS; mla_prep_phase(P, l, lds, wid, bid - NSCAN, G - NSCAN); }
              GROUP_BAR();
              { int w_ = wid0, b_ = (int)blockIdx.x; OPAQUE_S(w_); OPAQUE_S(b_); if (b_ == NSCAN) flag_set(flags + 64 * (1 + l), w_); }
          }
        }
        __syncthreads();
        { PHASE_IDS; (void)bid; (void)G; att::attn_phase(P, l, lds, (unsigned*)(ws + WS_CTL) + 64 * (16 + 2 * l), wid); }
        GRID_BAR();
        { PHASE_IDS; (void)bid; (void)G; wkv::post_phase(P, l, wid); }
        GRID_BAR();
        {
            PHASE_IDS;
            pg8::Gemm g{(const bf16_t*)(ws + WS_XB), (const bf16_t*)(ws + WS_WOUT(l)), NTOK, DM, DM, DM};
            pg8::EpiResidual E{l == 0 ? P.in[0] : P.out, P.out, DM, 0};
            pg8::StaticOrder S; S.init(NTOK, DM, G, bid);
            pg8::gemm_phase<pg8::EpiResidual, pg8::StaticOrder, true>(lds, g, S, E, wid);
        }
        if (l == 0) GRID_BAR();
    }
#undef PHASE_IDS
#undef GRID_BAR
#undef GROUP_BAR
}

extern "C" void kernel_launch(void* const* d_in, const int* in_sizes, int n_in, void* d_out, int out_size, void* d_ws, size_t ws_size, hipStream_t stream) {
    if (n_in != 36 || out_size != NTOK * DM || ws_size < WS_END) { fprintf(stderr, "kernel_launch: unexpected shapes (n_in %d out %d ws %zu)\n", n_in, out_size, ws_size); return; }
    Params P{};
    for (int i = 0; i < 36; ++i) P.in[i] = (const float*)d_in[i];
    P.out = (float*)d_out; P.ws = (unsigned char*)d_ws;
    constexpr size_t kDynLds = 147456;
    static int coop_grid = 0;
    if (!coop_grid) {
        int dev = 0, cus = 0, per_cu = 0;
        (void)hipGetDevice(&dev); (void)hipDeviceGetAttribute(&cus, hipDeviceAttributeMultiprocessorCount, dev);
        (void)hipFuncSetAttribute((const void*)k_mega, hipFuncAttributeMaxDynamicSharedMemorySize, (int)kDynLds);
        (void)hipOccupancyMaxActiveBlocksPerMultiprocessor(&per_cu, (const void*)k_mega, 512, kDynLds);
        coop_grid = cus * per_cu;
        if (coop_grid <= 0) { fprintf(stderr, "kernel_launch: occupancy query gave %d x %d\n", cus, per_cu); coop_grid = 0; return; }
    }
    (void)hipMemsetAsync((unsigned char*)d_ws + WS_CTL, 0, 131072, stream);
    void* args[] = {&P};
    hipError_t e = hipLaunchCooperativeKernel((const void*)k_mega, dim3(coop_grid), dim3(512), args, kDynLds, stream);
    if (e != hipSuccess) fprintf(stderr, "cooperative launch failed: %s (grid %d)\n", hipGetErrorString(e), coop_grid);
}
```

```cpp
#include <hip/hip_runtime.h>
#include <hip/hip_cooperative_groups.h>
#include <cstdio>
#include <cstdint>
namespace cg = cooperative_groups;

typedef unsigned short bf16_t;
typedef short bf16x8 __attribute__((ext_vector_type(8)));
typedef float f32x4 __attribute__((ext_vector_type(4)));
typedef float f32x16 __attribute__((ext_vector_type(16)));
typedef unsigned u32x4 __attribute__((ext_vector_type(4)));
typedef unsigned u32x2 __attribute__((ext_vector_type(2)));
#define LAS __attribute__((address_space(3)))

constexpr int NTOK = 16384, DM = 2048, TT = 4096, NBATCH = 4, NP = 7936, NIN = 7944;
constexpr int C_Z = 0, C_RWR = 2048, C_RWK = 2560, C_RWV = 3072, C_RWWD = 3584;
constexpr int C_MLQ = 3648, C_MLK = 4160, C_MLV = 4672, C_MLO = 5184;
constexpr int C_QLAT = 5696, C_KVLAT = 6080, C_KPE = 6336;
constexpr int C_DAQ = 6400, C_DAK = 6912, C_DAV = 7424;
constexpr int Y_RW = 0, Y_ML = 512, Y_MLA = 1024, Y_DA = 1536;
constexpr int GATE_COL = 5696;

constexpr size_t MiB = 1u << 20;
constexpr size_t WS_CTL = 0;
__host__ __device__ constexpr size_t WS_WIN(int l) { return (1 + 31 * (size_t)l) * MiB; }
__host__ __device__ constexpr size_t WS_WOUT(int l) { return (63 + 8 * (size_t)l) * MiB; }
__host__ __device__ constexpr size_t WS_WQ(int l) { return 79 * MiB + (size_t)l * 655360; }
__host__ __device__ constexpr size_t WS_WKV(int l) { return 79 * MiB + 2 * 655360 + (size_t)l * 524288; }
__host__ __device__ constexpr size_t WS_WG(int l) { return 79 * MiB + 2 * 655360 + 2 * 524288 + (size_t)l * 65536; }
constexpr size_t WS_ROPE = 81 * MiB + 524288;
constexpr size_t WS_RSTD = 83 * MiB;
constexpr size_t WS_VDNT = 83 * MiB + 131072;
constexpr size_t WS_GATES = 83 * MiB + 524288;
constexpr size_t WS_VL = 84 * MiB;
constexpr size_t WS_XB = 86 * MiB;
constexpr size_t WS_P = 150 * MiB;
constexpr size_t WS_QRAW = 398 * MiB;
constexpr size_t WS_KVRAW = 422 * MiB;
constexpr size_t WS_KMLA = 454 * MiB;
constexpr size_t WS_VFIRST = 478 * MiB;
constexpr size_t WS_BV = 494 * MiB;
constexpr size_t WS_END = 510 * MiB;

struct Params { const float* in[36]; float* out; unsigned char* ws; };

__device__ __forceinline__ float bf2f(bf16_t v) { return __uint_as_float((unsigned)v << 16); }
__device__ __forceinline__ unsigned f2bf(float f) { unsigned u = __float_as_uint(f); return (u + 0x7fffu + ((u >> 16) & 1u)) >> 16; }
__device__ __forceinline__ unsigned pk2(float lo, float hi) { return f2bf(lo) | (f2bf(hi) << 16); }
__device__ __forceinline__ float dpp_sel(float v, const int sel) {
    const int x = __builtin_bit_cast(int, v); int r;
    if (sel == 0) r = __builtin_amdgcn_update_dpp(0, x, 0xB1, 0xF, 0xF, true);
    else if (sel == 1) r = __builtin_amdgcn_update_dpp(0, x, 0x4E, 0xF, 0xF, true);
    else if (sel == 2) r = __builtin_amdgcn_update_dpp(0, x, 0x141, 0xF, 0xF, true);
    else r = __builtin_amdgcn_update_dpp(0, x, 0x140, 0xF, 0xF, true);
    return __builtin_bit_cast(float, r);
}
__device__ __forceinline__ float wave_sum(float v) {
    v += dpp_sel(v, 0); v += dpp_sel(v, 1); v += dpp_sel(v, 2); v += dpp_sel(v, 3);
    const int x = __builtin_bit_cast(int, v);
    const float s0 = __builtin_bit_cast(float, __builtin_amdgcn_readlane(x, 0)), s1 = __builtin_bit_cast(float, __builtin_amdgcn_readlane(x, 16));
    const float s2 = __builtin_bit_cast(float, __builtin_amdgcn_readlane(x, 32)), s3 = __builtin_bit_cast(float, __builtin_amdgcn_readlane(x, 48));
    return (s0 + s1) + (s2 + s3);
}
__device__ __forceinline__ float xor32_get(float v) { int l_; asm volatile("v_mbcnt_lo_u32_b32 %0, -1, 0\n\tv_mbcnt_hi_u32_b32 %0, -1, %0" : "=v"(l_));
    return __builtin_bit_cast(float, __builtin_amdgcn_ds_bpermute((l_ ^ 32) << 2, __builtin_bit_cast(int, v))); }
__device__ __forceinline__ float xor32_sum(float v) { return v + xor32_get(v); }
__device__ __forceinline__ float xor32_max(float v) { return fmaxf(v, xor32_get(v)); }
__device__ __forceinline__ float xor32_max_fast(float v) { float a = v, b; asm volatile("s_nop 1\n\tv_mov_b32 %1, %0\n\ts_nop 1\n\tv_permlane32_swap_b32 %0, %1\n\ts_nop 1" : "+v"(a), "=&v"(b)); return fmaxf(a, b); }
__device__ __forceinline__ float scan_sum64(float v) {
#define SC_STEP(ctrl, rm) v += __builtin_bit_cast(float, __builtin_amdgcn_update_dpp(0, __builtin_bit_cast(int, v), ctrl, rm, 0xF, false))
    SC_STEP(0x111, 0xF); SC_STEP(0x112, 0xF); SC_STEP(0x114, 0xF); SC_STEP(0x118, 0xF); SC_STEP(0x142, 0xA); SC_STEP(0x143, 0xC);
#undef SC_STEP
    return v;
}
__device__ __forceinline__ float scan_max64(float v) {
    const int ninf = (int)0xff800000u;
#define SC_STEP(ctrl, rm) v = fmaxf(v, __builtin_bit_cast(float, __builtin_amdgcn_update_dpp(ninf, __builtin_bit_cast(int, v), ctrl, rm, 0xF, false)))
    SC_STEP(0x111, 0xF); SC_STEP(0x112, 0xF); SC_STEP(0x114, 0xF); SC_STEP(0x118, 0xF); SC_STEP(0x142, 0xA); SC_STEP(0x143, 0xC);
#undef SC_STEP
    return v;
}
__device__ __forceinline__ float lane63(float v) { return __builtin_bit_cast(float, __builtin_amdgcn_readlane(__builtin_bit_cast(int, v), 63)); }
__device__ __forceinline__ float softplusf_(float x) { return x > 20.f ? x : log1pf(expf(x)); }
#define LDS_WAIT() asm volatile("s_waitcnt lgkmcnt(0)" ::: "memory")
#define LDS_BARRIER() do { asm volatile("s_waitcnt lgkmcnt(0)" ::: "memory"); __builtin_amdgcn_s_barrier(); asm volatile("" ::: "memory"); } while (0)
__device__ __forceinline__ int lane_id_opaque() { int l; asm volatile("v_mbcnt_lo_u32_b32 %0, -1, 0\n\tv_mbcnt_hi_u32_b32 %0, -1, %0" : "=v"(l)); return l; }
#define PHASE_TID(wid) ((wid) * 64 + lane_id_opaque())
#define OPAQUE_S(x) asm volatile("" : "+s"(x))

__device__ __forceinline__ void sincos_d(double x, double& s, double& c) {
    const double k = rint(x * 0.6366197723675814);
    double r = fma(-k, 1.5707963267948966, x); r = fma(-k, 6.123233995736766e-17, r);
    const int q = (int)((long long)k) & 3;
    const double r2 = r * r;
    const double sp = r * (1.0 + r2 * (-1.0 / 6 + r2 * (1.0 / 120 + r2 * (-1.0 / 5040 + r2 * (1.0 / 362880 + r2 * (-1.0 / 39916800 + r2 * (1.0 / 6227020800.0)))))));
    const double cp = 1.0 + r2 * (-0.5 + r2 * (1.0 / 24 + r2 * (-1.0 / 720 + r2 * (1.0 / 40320 + r2 * (-1.0 / 3628800 + r2 * (1.0 / 479001600.0 + r2 * (-1.0 / 87178291200.0)))))));
    if (q == 0) { s = sp; c = cp; } else if (q == 1) { s = cp; c = -sp; } else if (q == 2) { s = -sp; c = -cp; } else { s = -cp; c = sp; }
}
__device__ __forceinline__ float inv_mla(int i) {
    const float t[32] = {1.000000000e+00f, 6.636012793e-01f, 4.403665960e-01f, 2.922278047e-01f, 1.939227432e-01f, 1.286873668e-01f, 8.539710194e-02f, 5.666962266e-02f, 3.760603070e-02f, 2.495540865e-02f, 1.656043902e-02f, 1.098952908e-02f, 7.292664610e-03f, 4.839421250e-03f, 3.211445874e-03f, 2.131119603e-03f, 1.414213562e-03f, 9.384738514e-04f, 6.227723788e-04f, 4.132725589e-04f, 2.742481884e-04f, 1.819914323e-04f, 1.207697351e-04f, 8.014294872e-05f, 5.318296098e-05f, 3.529227615e-05f, 2.341999971e-05f, 1.554154005e-05f, 1.031338616e-05f, 6.843975370e-06f, 4.541670478e-06f, 3.013858077e-06f};
    float r = t[0];
#pragma unroll
    for (int j = 1; j < 32; ++j) r = (i == j) ? t[j] : r;
    return r;
}
__device__ __forceinline__ float inv_da(int i) {
    const float t[8] = {1.000000000e+00f, 1.939227432e-01f, 3.760603070e-02f, 7.292664610e-03f, 1.414213562e-03f, 2.742481884e-04f, 5.318296098e-05f, 1.031338616e-05f};
    float r = t[0];
#pragma unroll
    for (int j = 1; j < 8; ++j) r = (i == j) ? t[j] : r;
    return r;
}

namespace pg8 {
constexpr int BM = 256, BK = 64, HALF = 128, HTB = HALF * BK * 2, STAGE_BYTES = 8 * HTB, NXCD = 8, WGM = 8;
__host__ __device__ __forceinline__ int lds_byte(int r, int c) { const int st = (r >> 4) * 2 + (c >> 5), rr = r & 15, cc = c & 31, ob = rr * 64 + cc * 2; return st * 1024 + (ob ^ (((ob >> 9) & 1) << 5)); }
__host__ __device__ __forceinline__ void stage_rc(int b, int& R, int& C) { const int st = b / 1024, sb = b % 1024, swz = sb ^ (((sb >> 9) & 1) << 5); R = (st >> 1) * 16 + swz / 64; C = (st & 1) * 32 + (swz % 64) / 2; }
__host__ __device__ __forceinline__ int perm32(int rho) { const int n = rho >> 4, i = rho & 15; return 8 * (i >> 2) + 4 * n + (i & 3); }
struct Unit { int pm, pn; };
struct Gemm { const bf16_t* A; const bf16_t* Bt; int M, N, K, lda; };
struct StaticOrder {
    int nM, nN, nwg, G, c;
    __host__ __device__ void init(int M, int N, int G_, int c_) { nM = M / BM; nN = N / BM; nwg = nM * nN; G = G_; c = c_; }
    __host__ __device__ bool next(int i, Unit& u) const {
        const long L = (long)i * G + c; if (L >= nwg) return false;
        int wgid = (int)L; { const int q = nwg / NXCD, r = nwg % NXCD, xcd = wgid % NXCD, off = wgid / NXCD; wgid = (xcd < r ? xcd * (q + 1) : r * (q + 1) + (xcd - r) * q) + off; }
        const int nig = WGM * nN, gid = wgid / nig, fm = gid * WGM, gsz = (nM - fm) < WGM ? (nM - fm) : WGM;
        u.pm = fm + ((wgid % nig) % gsz); u.pn = (wgid % nig) / gsz; return true;
    }
};
__device__ __forceinline__ unsigned cvt_pk_bf16(float lo, float hi) { unsigned r; asm volatile("v_cvt_pk_bf16_f32 %0, %1, %2" : "=v"(r) : "v"(lo), "v"(hi)); return r; }

struct EpiRowScaleBf16 {
    static constexpr bool PERM = true;
    bf16_t* O; const float* rs; int ldc; int pad;
    __device__ __forceinline__ void operator()(const f32x4 (&acc)[2][2][4][2], const Unit& u, int wr, int wc, int fr, int fq) const {
        const int row0 = u.pm * BM + wr * 64 + fr, col0 = u.pn * BM + wc * 32 + 8 * fq;
#pragma unroll
        for (int ai = 0; ai < 2; ++ai)
#pragma unroll
            for (int m = 0; m < 4; ++m) {
                const int row = row0 + ai * HALF + m * 16; const float sc = rs ? rs[row] : 1.f; bf16_t* rowp = O + (size_t)row * ldc + col0;
#pragma unroll
                for (int bj = 0; bj < 2; ++bj) { f32x4 v0 = acc[ai][bj][m][0] * sc, v1 = acc[ai][bj][m][1] * sc;
                    u32x4 w; w.x = cvt_pk_bf16(v0[0], v0[1]); w.y = cvt_pk_bf16(v0[2], v0[3]); w.z = cvt_pk_bf16(v1[0], v1[1]); w.w = cvt_pk_bf16(v1[2], v1[3]);
                    *(u32x4*)(rowp + bj * HALF) = w; } }
    }
};
struct EpiResidual {
    static constexpr bool PERM = false;
    const float* base; float* out; int ldc; int pad;
    __device__ __forceinline__ void operator()(const f32x4 (&acc)[2][2][4][2], const Unit& u, int wr, int wc, int fr, int fq) const {
        const int col0 = u.pn * BM + wc * 32 + 4 * fq;
#pragma unroll
        for (int ai = 0; ai < 2; ++ai)
#pragma unroll
            for (int m = 0; m < 4; ++m) { const size_t off = (size_t)(u.pm * BM + ai * HALF + wr * 64 + m * 16 + fr) * ldc + col0;
#pragma unroll
                for (int bj = 0; bj < 2; ++bj)
#pragma unroll
                    for (int n = 0; n < 2; ++n) { const f32x4 bs = *(const f32x4*)(base + off + bj * HALF + n * 16); *(f32x4*)(out + off + bj * HALF + n * 16) = bs + acc[ai][bj][m][n]; } }
    }
};

template <class Epi, class Sched, bool ALIGN_EPI>
__device__ __forceinline__ void gemm_phase(LAS unsigned char* lds, const Gemm g, const Sched& S, const Epi& E, const int wid) {
    const int tid = PHASE_TID(wid);
    const int lane = tid & 63, wr = wid >> 2, wc = wid & 3, fr = lane & 15, fq = lane >> 4;
    const int K = g.K, nt = K / BK, lda = g.lda;
    unsigned voffA[2], voffB[2];
#pragma unroll
    for (int i = 0; i < 2; ++i) { int R, C; stage_rc(tid * 16 + i * 8192, R, C); const int Rb = Epi::PERM ? ((R & ~31) + perm32(R & 31)) : R;
        voffA[i] = (unsigned)(R * lda + C) * 2u; voffB[i] = (unsigned)(Rb * K + C) * 2u; }
    const size_t kstep = (size_t)(BK * 2);
    const size_t hstepA = (size_t)HALF * lda * 2, hstepB = (size_t)HALF * K * 2;
    const size_t tstepA = 2 * hstepA, tstepB = 2 * hstepB;
    const unsigned ldsw = (unsigned)wid * 1024u;
    const int aoff = lds_byte(wr * 64 + fr, fq * 8), boff = lds_byte(wc * 32 + fr, fq * 8);
#define PG8_SA(b, h) (((b) * 2 + (h)) * HTB)
#define PG8_SB(b, h) ((4 + (b) * 2 + (h)) * HTB)
#define PG8_STAGE(bufoff, gbase, voff) do { _Pragma("unroll") for (int _i = 0; _i < 2; ++_i) \
        __builtin_amdgcn_global_load_lds((const unsigned*)((const char*)(gbase) + (voff)[_i]), (LAS unsigned*)(lds + (bufoff) + ldsw + _i * 8192), 16, 0, 0); } while (0)
#define PG8_LDA(dst, b, h) do { _Pragma("unroll") for (int m = 0; m < 4; ++m) _Pragma("unroll") for (int k = 0; k < 2; ++k) dst[m][k] = *(const LAS bf16x8*)(lds + PG8_SA(b, h) + aoff + m * 2048 + k * 1024); } while (0)
#define PG8_LDB(dst, b, h) do { _Pragma("unroll") for (int n = 0; n < 2; ++n) _Pragma("unroll") for (int k = 0; k < 2; ++k) dst[n][k] = *(const LAS bf16x8*)(lds + PG8_SB(b, h) + boff + n * 2048 + k * 1024); } while (0)
#define PG8_MMA(ai, bj, At, Bt) do { __builtin_amdgcn_s_setprio(1); _Pragma("unroll") for (int m = 0; m < 4; ++m) _Pragma("unroll") for (int n = 0; n < 2; ++n) _Pragma("unroll") for (int k = 0; k < 2; ++k) \
        acc[ai][bj][m][n] = __builtin_amdgcn_mfma_f32_16x16x32_bf16(Bt[n][k], At[m][k], acc[ai][bj][m][n], 0, 0, 0); __builtin_amdgcn_s_setprio(0); } while (0)
#define PG8_WAIT_V(n) asm volatile("s_waitcnt vmcnt(" #n ")" ::: "memory")
#define PG8_WAIT_L(n) asm volatile("s_waitcnt lgkmcnt(" #n ")" ::: "memory")
#define PG8_BAR __builtin_amdgcn_s_barrier()
#define PG8_SCHED __builtin_amdgcn_sched_barrier(0)
    Unit cur, nxt; int ui = 0;
    if (!S.next(0, cur)) return;
    f32x4 acc[2][2][4][2];
#pragma unroll
    for (int a = 0; a < 2; ++a)
#pragma unroll
        for (int b = 0; b < 2; ++b)
#pragma unroll
            for (int m = 0; m < 4; ++m)
#pragma unroll
                for (int n = 0; n < 2; ++n) acc[a][b][m][n] = (f32x4){0.f, 0.f, 0.f, 0.f};
    bf16x8 At[4][2], B0[2][2], B1[2][2];
    const char* cA = (const char*)g.A + (size_t)cur.pm * tstepA; const char* cB = (const char*)g.Bt + (size_t)cur.pn * tstepB;
    PG8_STAGE(PG8_SB(0, 0), cB, voffB); PG8_STAGE(PG8_SB(0, 1), cB + hstepB, voffB); PG8_STAGE(PG8_SA(0, 0), cA, voffA); PG8_STAGE(PG8_SA(0, 1), cA + hstepA, voffA);
    if (wr == 1) PG8_BAR;
    PG8_WAIT_V(2); PG8_BAR;
    PG8_STAGE(PG8_SB(1, 0), cB + kstep, voffB); PG8_STAGE(PG8_SA(1, 0), cA + kstep, voffA); PG8_STAGE(PG8_SB(1, 1), cB + hstepB + kstep, voffB);
    PG8_WAIT_V(6); PG8_BAR;
    for (;;) {
        const bool has_next = S.next(ui + 1, nxt);
        const char* nA = has_next ? (const char*)g.A + (size_t)nxt.pm * tstepA : cA; const char* nB = has_next ? (const char*)g.Bt + (size_t)nxt.pn * tstepB : cB;
        for (int t = 0; t < nt; t += 2) {
            const bool last = (t == nt - 2);
            const char* a1 = cA + (size_t)(t + 1) * kstep;
            const char* a2 = last ? nA : cA + (size_t)(t + 2) * kstep; const char* b2 = last ? nB : cB + (size_t)(t + 2) * kstep;
            const char* a3 = a2 + kstep; const char* b3 = b2 + kstep;
            PG8_LDB(B0, 0, 0); PG8_LDB(B1, 0, 1); PG8_SCHED; PG8_LDA(At, 0, 0); PG8_STAGE(PG8_SA(1, 1), a1 + hstepA, voffA);
            PG8_WAIT_V(8); PG8_WAIT_L(0); PG8_BAR; PG8_MMA(0, 0, At, B0); PG8_MMA(0, 1, At, B1); PG8_BAR; PG8_SCHED;
            PG8_LDA(At, 0, 1); PG8_STAGE(PG8_SB(0, 0), b2, voffB); PG8_STAGE(PG8_SB(0, 1), b2 + hstepB, voffB); PG8_STAGE(PG8_SA(0, 0), a2, voffA);
            PG8_WAIT_V(8); PG8_WAIT_L(0); PG8_BAR; PG8_MMA(1, 0, At, B0); PG8_MMA(1, 1, At, B1); PG8_BAR; PG8_SCHED;
            PG8_LDB(B0, 1, 0); PG8_LDB(B1, 1, 1); PG8_SCHED; PG8_LDA(At, 1, 0); PG8_STAGE(PG8_SA(0, 1), a2 + hstepA, voffA);
            PG8_WAIT_V(8); PG8_WAIT_L(0); PG8_BAR; PG8_MMA(0, 0, At, B0); PG8_MMA(0, 1, At, B1); PG8_BAR; PG8_SCHED;
            PG8_LDA(At, 1, 1); PG8_STAGE(PG8_SB(1, 0), b3, voffB); PG8_STAGE(PG8_SB(1, 1), b3 + hstepB, voffB); PG8_STAGE(PG8_SA(1, 0), a3, voffA);
            PG8_WAIT_V(8); PG8_WAIT_L(0); PG8_BAR; PG8_MMA(1, 0, At, B0); PG8_MMA(1, 1, At, B1); PG8_BAR; PG8_SCHED;
        }
        if constexpr (ALIGN_EPI) { if (wr == 0) PG8_BAR; }
        E(acc, cur, wr, wc, fr, fq);
        if (!has_next) break;
#pragma unroll
        for (int a = 0; a < 2; ++a)
#pragma unroll
            for (int b = 0; b < 2; ++b)
#pragma unroll
                for (int m = 0; m < 4; ++m)
#pragma unroll
                    for (int n = 0; n < 2; ++n) acc[a][b][m][n] = (f32x4){0.f, 0.f, 0.f, 0.f};
        cur = nxt; cA = nA; cB = nB; ++ui;
        if constexpr (ALIGN_EPI) { if (wr == 1) PG8_BAR; }
    }
    PG8_WAIT_V(0);
    if constexpr (!ALIGN_EPI) { if (wr == 0) PG8_BAR; }
    PG8_BAR;
#undef PG8_SA
#undef PG8_SB
#undef PG8_STAGE
#undef PG8_LDA
#undef PG8_LDB
#undef PG8_MMA
#undef PG8_WAIT_V
#undef PG8_WAIT_L
#undef PG8_BAR
#undef PG8_SCHED
}
}

__device__ __forceinline__ void tr_item(const float* __restrict__ W, int ldw, int k0, int nsrc0, const float* __restrict__ g, bf16_t* WT, int K, int ndst0, LAS float* scr, int lane) {
    const int c4 = lane & 7, r8 = lane >> 3;
    f32x4 v[8];
#pragma unroll
    for (int i = 0; i < 8; ++i) v[i] = *(const f32x4*)(W + (size_t)(k0 + r8 + 8 * i) * ldw + nsrc0 + 4 * c4);
    f32x4 g0 = {1.f, 1.f, 1.f, 1.f}, g1 = g0;
    if (g) { g0 = *(const f32x4*)(g + k0 + 8 * c4); g1 = *(const f32x4*)(g + k0 + 8 * c4 + 4); }
#pragma unroll
    for (int i = 0; i < 8; ++i) *(LAS f32x4*)(scr + (r8 + 8 * i) * 36 + 4 * c4) = v[i];
    LDS_WAIT();
    const int c = lane & 7;
#pragma unroll
    for (int j = 0; j < 4; ++j) { const int n = (lane >> 3) + 8 * j; const LAS float* s = scr + (8 * c) * 36 + n;
        u32x4 o; o.x = pk2(s[0 * 36] * g0[0], s[1 * 36] * g0[1]); o.y = pk2(s[2 * 36] * g0[2], s[3 * 36] * g0[3]); o.z = pk2(s[4 * 36] * g1[0], s[5 * 36] * g1[1]); o.w = pk2(s[6 * 36] * g1[2], s[7 * 36] * g1[3]);
        *(u32x4*)(WT + (size_t)(ndst0 + n) * K + k0 + 8 * c) = o; }
    LDS_WAIT();
}

__device__ __forceinline__ void prologue_phase(const Params& P, LAS unsigned char* lds, const int wid) {
    const int tid = PHASE_TID(wid), lane = tid & 63, wave = wid, nw = blockDim.x >> 6;
    const int gw = blockIdx.x * nw + wave, NGW = gridDim.x * nw;
    LAS float* scr = (LAS float*)lds + wave * (64 * 36);
    constexpr int I_IN = 32 * (NP / 32), I_OUT = 32 * (DM / 32), I_Q = 6 * 24, I_KV = 4 * 32, I_L = I_IN + I_OUT + I_Q + I_KV;
    for (int it = gw; it < 2 * I_L; it += NGW) {
        const int l = it / I_L; int r = it % I_L;
        unsigned char* ws = P.ws;
        if (r < I_IN) { const int nb = r % (NP / 32), kb = r / (NP / 32), n0 = nb * 32; const int ns = n0 >= GATE_COL ? n0 + 8 : n0;
            tr_item(P.in[2] + (size_t)l * DM * NIN, NIN, kb * 64, ns, P.in[1] + l * DM, (bf16_t*)(ws + WS_WIN(l)), DM, n0, scr, lane); continue; }
        r -= I_IN;
        if (r < I_OUT) { const int nb = r % (DM / 32), kb = r / (DM / 32);
            tr_item(P.in[3] + (size_t)l * DM * DM, DM, kb * 64, nb * 32, nullptr, (bf16_t*)(ws + WS_WOUT(l)), DM, nb * 32, scr, lane); continue; }
        r -= I_OUT;
        if (r < I_Q) { const int nb = r % 24, kb = r / 24;
            tr_item(P.in[25] + (size_t)l * 384 * 768, 768, kb * 64, nb * 32, P.in[23] + l * 384, (bf16_t*)(ws + WS_WQ(l)), 384, nb * 32, scr, lane); continue; }
        r -= I_Q;
        { const int nb = r % 32, kb = r / 32;
            tr_item(P.in[26] + (size_t)l * 256 * 1024, 1024, kb * 64, nb * 32, P.in[24] + l * 256, (bf16_t*)(ws + WS_WKV(l)), 256, nb * 32, scr, lane); }
    }
    const int gt = blockIdx.x * blockDim.x + tid, NGT = gridDim.x * blockDim.x;
    for (int i = gt; i < 2 * 8 * DM; i += NGT) { const int l = i / (8 * DM), j = (i / DM) % 8, k = i % DM;
        ((float*)(P.ws + WS_WG(l)))[j * DM + k] = P.in[1][l * DM + k] * P.in[2][(size_t)l * DM * NIN + (size_t)k * NIN + GATE_COL + j]; }
    for (int i = gt; i < 32 * 512; i += NGT) { const int j = i >> 9, c = i & 511; ((bf16_t*)(P.ws + WS_VDNT))[i] = (bf16_t)f2bf(P.in[11][c * 32 + j]); }
    float* rope = (float*)(P.ws + WS_ROPE);
    for (int i = gt; i < TT * 32; i += NGT) { const int t = i >> 5, j = i & 31; const float ang = (float)t * inv_mla(j); double s, c; sincos_d((double)ang, s, c); rope[i] = (float)c; rope[TT * 32 + i] = (float)s; }
    for (int i = gt; i < TT * 8; i += NGT) { const int t = i >> 3, j = i & 7; const float ang = (float)t * inv_da(j); double s, c; sincos_d((double)ang, s, c); rope[2 * TT * 32 + i] = (float)c; rope[2 * TT * 32 + TT * 8 + i] = (float)s; }
}

__device__ __forceinline__ void p1_phase(const Params& P, int l, LAS unsigned char* lds, const int wid) {
    const int tid = PHASE_TID(wid), lane = tid & 63, wave = wid, nw = blockDim.x >> 6;
    const int gw = blockIdx.x * nw + wave, NGW = gridDim.x * nw;
    const float* x = l == 0 ? P.in[0] : P.out;
    bf16_t* xb = (bf16_t*)(P.ws + WS_XB); float* rstd = (float*)(P.ws + WS_RSTD); float* gates = (float*)(P.ws + WS_GATES);
    { const f32x4* wg = (const f32x4*)(P.ws + WS_WG(l)); LAS f32x4* wl = (LAS f32x4*)lds;
#pragma unroll
      for (int i = 0; i < 8; ++i) wl[tid + 512 * i] = wg[tid + 512 * i]; }
    __syncthreads();
    const LAS f32x4* wl = (const LAS f32x4*)lds + lane;
    f32x4 v[8], nx[8];
    if (gw < NTOK) { const f32x4* xr = (const f32x4*)(x + (size_t)gw * DM);
#pragma unroll
        for (int j = 0; j < 8; ++j) nx[j] = xr[lane + 64 * j]; }
    for (int row = gw; row < NTOK; row += NGW) {
        float ss = 0.f;
#pragma unroll
        for (int j = 0; j < 8; ++j) { v[j] = nx[j]; ss += v[j][0] * v[j][0] + v[j][1] * v[j][1] + v[j][2] * v[j][2] + v[j][3] * v[j][3]; }
        if (row + NGW < NTOK) { const f32x4* xr = (const f32x4*)(x + (size_t)(row + NGW) * DM);
#pragma unroll
            for (int j = 0; j < 8; ++j) nx[j] = xr[lane + 64 * j]; }
        ss = wave_sum(ss);
        const float rs = rsqrtf(ss * (1.0f / DM) + 1e-6f);
#pragma unroll
        for (int j = 0; j < 8; ++j) { u32x2 o; o.x = pk2(v[j][0], v[j][1]); o.y = pk2(v[j][2], v[j][3]); *(u32x2*)(xb + (size_t)row * DM + 4 * (lane + 64 * j)) = o; }
        float gv = 0.f;
#pragma unroll 2
        for (int g = 0; g < 8; ++g) { float d = 0.f;
#pragma unroll
            for (int j = 0; j < 8; ++j) { const f32x4 ww = wl[g * 512 + 64 * j]; d += v[j][0] * ww[0] + v[j][1] * ww[1] + v[j][2] * ww[2] + v[j][3] * ww[3]; }
            d = wave_sum(d); if (lane == g) gv = d * rs; }
        if (lane < 8) gates[row * 8 + lane] = gv;
        if (lane == 0) rstd[row] = rs;
    }
    __syncthreads();
}

__device__ __forceinline__ float dppx(float v, const int sel) {
    const int x = __builtin_bit_cast(int, v); int r;
    if (sel == 0) r = __builtin_amdgcn_update_dpp(0, x, 0xB1, 0xF, 0xF, true);
    else if (sel == 1) r = __builtin_amdgcn_update_dpp(0, x, 0x4E, 0xF, 0xF, true);
    else if (sel == 2) r = __builtin_amdgcn_update_dpp(0, x, 0x141, 0xF, 0xF, true);
    else r = __builtin_amdgcn_update_dpp(0, x, 0x140, 0xF, 0xF, true);
    return __builtin_bit_cast(float, r);
}
__device__ __forceinline__ float sum4(float v) { v += dppx(v, 0); v += dppx(v, 1); return v; }
__device__ __forceinline__ float sum8(float v) { v = sum4(v); v += dppx(v, 2); return v; }
__device__ __forceinline__ float sum16(float v) { v = sum8(v); v += dppx(v, 3); return v; }
__device__ __forceinline__ float sum64(float v) {
    v = sum16(v); const int x = __builtin_bit_cast(int, v);
    const float s0 = __builtin_bit_cast(float, __builtin_amdgcn_readlane(x, 0)), s1 = __builtin_bit_cast(float, __builtin_amdgcn_readlane(x, 16));
    const float s2 = __builtin_bit_cast(float, __builtin_amdgcn_readlane(x, 32)), s3 = __builtin_bit_cast(float, __builtin_amdgcn_readlane(x, 48));
    return (s0 + s1) + (s2 + s3);
}
__device__ __forceinline__ float blo(unsigned w) { return __uint_as_float(w << 16); }
__device__ __forceinline__ float bhi(unsigned w) { return __uint_as_float(w & 0xffff0000u); }

__device__ __forceinline__ void vl_phase(const Params& P, const int wid, const int bid, const int G) {
    const int tid = PHASE_TID(wid);
    const int lane = tid & 63, r32 = lane & 31, hh = lane >> 5, nw = blockDim.x >> 6;
    const bf16_t* p = (const bf16_t*)(P.ws + WS_P); const bf16_t* vdt = (const bf16_t*)(P.ws + WS_VDNT); bf16_t* vlb = (bf16_t*)(P.ws + WS_VL);
    const float* mu = P.in[5] + 1 * 1600 + 1024;
    for (int tile = bid * nw + wid; tile < NTOK / 32; tile += G * nw) {
        const int tok = tile * 32 + r32, t = tok % TT;
        const bf16_t* cur = p + (size_t)tok * NP + C_RWV + 8 * hh;
        f32x16 acc;
#pragma unroll
        for (int r = 0; r < 16; ++r) acc[r] = 0.f;
#pragma unroll 4
        for (int ks = 0; ks < 32; ++ks) {
            const u32x4 c4 = *(const u32x4*)(cur + 16 * ks); u32x4 p4 = *(const u32x4*)(cur + 16 * ks - (t > 0 ? NP : 0));
            if (t == 0) p4 = (u32x4){0u, 0u, 0u, 0u};
            const f32x4 m0 = *(const f32x4*)(mu + 16 * ks + 8 * hh), m1 = *(const f32x4*)(mu + 16 * ks + 8 * hh + 4);
            u32x4 w;
            { const float a0 = blo(c4.x), a1 = bhi(c4.x), a2 = blo(c4.y), a3 = bhi(c4.y), b0 = blo(p4.x), b1 = bhi(p4.x), b2 = blo(p4.y), b3 = bhi(p4.y);
              w.x = pk2(a0 + (b0 - a0) * m0[0], a1 + (b1 - a1) * m0[1]); w.y = pk2(a2 + (b2 - a2) * m0[2], a3 + (b3 - a3) * m0[3]); }
            { const float a0 = blo(c4.z), a1 = bhi(c4.z), a2 = blo(c4.w), a3 = bhi(c4.w), b0 = blo(p4.z), b1 = bhi(p4.z), b2 = blo(p4.w), b3 = bhi(p4.w);
              w.z = pk2(a0 + (b0 - a0) * m1[0], a1 + (b1 - a1) * m1[1]); w.w = pk2(a2 + (b2 - a2) * m1[2], a3 + (b3 - a3) * m1[3]); }
            const bf16x8 bfrag = *(const bf16x8*)(vdt + (size_t)r32 * 512 + 16 * ks + 8 * hh);
            acc = __builtin_amdgcn_mfma_f32_32x32x16_bf16(__builtin_bit_cast(bf16x8, w), bfrag, acc, 0, 0, 0);
        }
#pragma unroll
        for (int r = 0; r < 16; ++r) vlb[(size_t)(tile * 32 + (r & 3) + 8 * (r >> 2) + 4 * hh) * 32 + r32] = (bf16_t)f2bf(acc[r]);
    }
}

struct MRaw { unsigned ql[3], kl[2]; u32x2 qw[3]; unsigned k12[12]; u32x4 v; f32x4 cs[3], sn[3]; };
__device__ __forceinline__ void mla_load(MRaw& R, const Params& P, const int tok, const int lane) {
    const int hd = lane >> 4, d0 = 12 * (lane & 15), t = tok % TT;
    const bf16_t* prow = (const bf16_t*)(P.ws + WS_P) + (size_t)tok * NP;
    const unsigned* ql = (const unsigned*)(prow + C_QLAT) + 3 * lane; const unsigned* kl = (const unsigned*)(prow + C_KVLAT) + 2 * lane;
#pragma unroll
    for (int j = 0; j < 3; ++j) R.ql[j] = ql[j];
#pragma unroll
    for (int j = 0; j < 2; ++j) R.kl[j] = kl[j];
    const u32x2* qrow = (const u32x2*)((const bf16_t*)(P.ws + WS_QRAW) + (size_t)tok * 768 + 192 * hd + d0);
#pragma unroll
    for (int j = 0; j < 3; ++j) R.qw[j] = qrow[j];
    const bf16_t* kvr = (const bf16_t*)(P.ws + WS_KVRAW) + (size_t)tok * 1024 + 256 * hd;
#pragma unroll
    for (int j = 0; j < 12; ++j) { const int d = d0 + j; const bf16_t* src = d < 128 ? kvr + d : prow + (C_KPE - 128) + d; R.k12[j] = *src; }
    R.v = *(const u32x4*)(kvr + 128 + 8 * (lane & 15));
    const float* cosm = (const float*)(P.ws + WS_ROPE) + t * 32; const float* sinm = cosm + TT * 32;
#pragma unroll
    for (int k = 0; k < 3; ++k) { const int i = (d0 + 4 * k) & 31; R.cs[k] = *(const f32x4*)(cosm + i); R.sn[k] = *(const f32x4*)(sinm + i); }
}
__device__ __forceinline__ void mla_proc(const MRaw& R, const Params& P, const int tok, const int lane, LAS float* sq, LAS float* sk, const float (&gq)[12], const float (&gk)[12]) {
    const int hd = lane >> 4, d0 = 12 * (lane & 15);
    float s1 = 0.f, s2 = 0.f;
#pragma unroll
    for (int j = 0; j < 3; ++j) s1 += blo(R.ql[j]) * blo(R.ql[j]) + bhi(R.ql[j]) * bhi(R.ql[j]);
#pragma unroll
    for (int j = 0; j < 2; ++j) s2 += blo(R.kl[j]) * blo(R.kl[j]) + bhi(R.kl[j]) * bhi(R.kl[j]);
    const float rsq = rsqrtf(sum64(s1) * (1.0f / 384.f) + 1e-6f), rskv = rsqrtf(sum64(s2) * (1.0f / 256.f) + 1e-6f);
    float xq[12], xk[12]; float ssq = 0.f, ssk = 0.f;
#pragma unroll
    for (int j = 0; j < 3; ++j) { xq[4 * j] = blo(R.qw[j].x) * rsq; xq[4 * j + 1] = bhi(R.qw[j].x) * rsq; xq[4 * j + 2] = blo(R.qw[j].y) * rsq; xq[4 * j + 3] = bhi(R.qw[j].y) * rsq; }
#pragma unroll
    for (int j = 0; j < 12; ++j) { const int d = d0 + j; xk[j] = __uint_as_float(R.k12[j] << 16) * (d < 128 ? rskv : 1.0f); ssq += xq[j] * xq[j]; ssk += xk[j] * xk[j]; }
    const float rnq = rsqrtf(sum16(ssq) * (1.0f / 192.f) + 1e-6f), rnk = rsqrtf(sum16(ssk) * (1.0f / 192.f) + 1e-6f);
#pragma unroll
    for (int j = 0; j < 12; ++j) { xq[j] *= rnq * gq[j]; xk[j] *= rnk * gk[j]; sq[192 * hd + d0 + j] = xq[j]; sk[192 * hd + d0 + j] = xk[j]; }
    LDS_WAIT();
#pragma unroll
    for (int j = 0; j < 12; ++j) { const int d = d0 + j;
        const int dp = d < 128 ? d : (d < 160 ? d + 32 : d - 32);
        const float pq = sq[192 * hd + dp], pk = sk[192 * hd + dp];
        const float c_ = R.cs[j >> 2][j & 3], s_ = R.sn[j >> 2][j & 3];
        const float sg = d < 128 ? 0.f : (d < 160 ? -s_ : s_), cg = d < 128 ? 1.f : c_;
        xq[j] = xq[j] * cg + pq * sg; xk[j] = xk[j] * cg + pk * sg; }
    u32x2* qrow = (u32x2*)((bf16_t*)(P.ws + WS_QRAW) + (size_t)tok * 768 + 192 * hd + d0);
    u32x2* krow = (u32x2*)((bf16_t*)(P.ws + WS_KMLA) + (size_t)tok * 768 + 192 * hd + d0);
#pragma unroll
    for (int j = 0; j < 3; ++j) { u32x2 a, b2; a.x = pk2(xq[4 * j], xq[4 * j + 1]); a.y = pk2(xq[4 * j + 2], xq[4 * j + 3]); b2.x = pk2(xk[4 * j], xk[4 * j + 1]); b2.y = pk2(xk[4 * j + 2], xk[4 * j + 3]); qrow[j] = a; krow[j] = b2; }
    { u32x4 v = R.v;
#pragma unroll
      for (int j = 0; j < 4; ++j) v[j] = pk2(blo(v[j]) * rskv, bhi(v[j]) * rskv);
      *(u32x4*)((bf16_t*)(P.ws + WS_KVRAW) + (size_t)tok * 1024 + 256 * hd + 128 + 8 * (lane & 15)) = v; }
    LDS_WAIT();
}
__device__ __forceinline__ void mla_prep_phase(const Params& P, int l, LAS unsigned char* lds, const int wid, const int bid, const int G) {
    const int tid = PHASE_TID(wid);
    const int lane = tid & 63, nw = blockDim.x >> 6, d0 = 12 * (lane & 15);
    LAS float* sq = (LAS float*)lds + wid * 1536; LAS float* sk = sq + 768;
    const float* qg = P.in[27] + l * 192 + d0; const float* kg = P.in[28] + l * 192 + d0;
    float gq[12], gk[12];
#pragma unroll
    for (int j = 0; j < 12; ++j) { gq[j] = qg[j] * (0.07216878364870322f * 1.4426950408889634f); gk[j] = kg[j]; }
    const int stride = G * nw; int tok = bid * nw + wid;
    MRaw RA, RB;
    if (tok < NTOK) mla_load(RA, P, tok, lane);
#pragma unroll 1
    for (; tok < NTOK; tok += 2 * stride) {
        if (tok + stride < NTOK) mla_load(RB, P, tok + stride, lane);
        mla_proc(RA, P, tok, lane, sq, sk, gq, gk);
        if (tok + stride < NTOK) {
            if (tok + 2 * stride < NTOK) mla_load(RA, P, tok + 2 * stride, lane);
            mla_proc(RB, P, tok + stride, lane, sq, sk, gq, gk);
        }
    }
}

struct DRaw { u32x4 a, b; f32x4 c0, c1, s0, s1; };
__device__ __forceinline__ void da_load(DRaw& R, const Params& P, const int tok, const int lane) {
    const u32x4* ptr = (const u32x4*)((const bf16_t*)(P.ws + WS_P) + (size_t)tok * NP + C_DAQ + 16 * lane);
    R.a = ptr[0]; R.b = ptr[1];
    const float* cosd = (const float*)(P.ws + WS_ROPE) + 2 * TT * 32 + (tok % TT) * 8; const float* sind = cosd + TT * 8;
    R.c0 = *(const f32x4*)cosd; R.c1 = *(const f32x4*)(cosd + 4); R.s0 = *(const f32x4*)sind; R.s1 = *(const f32x4*)(sind + 4);
}
__device__ __forceinline__ void da_proc(const DRaw& R, const Params& P, const int tok, const int lane, const float (&gv)[16]) {
    float x[16];
#pragma unroll
    for (int j = 0; j < 4; ++j) { x[2 * j] = blo(R.a[j]); x[2 * j + 1] = bhi(R.a[j]); x[8 + 2 * j] = blo(R.b[j]); x[8 + 2 * j + 1] = bhi(R.b[j]); }
    float ss = 0.f;
#pragma unroll
    for (int j = 0; j < 16; ++j) ss += x[j] * x[j];
    const float r = rsqrtf(sum4(ss) * (1.0f / 64.f) + 1e-6f);
#pragma unroll
    for (int j = 0; j < 16; ++j) x[j] *= r * gv[j];
    const bool rot = (lane & 3) == 0;
#pragma unroll
    for (int i = 0; i < 8; ++i) { const float c = i < 4 ? R.c0[i & 3] : R.c1[i & 3], sn = i < 4 ? R.s0[i & 3] : R.s1[i & 3];
        const float x1 = x[i], x2 = x[8 + i]; const float y1 = x1 * c - x2 * sn, y2 = x2 * c + x1 * sn; x[i] = rot ? y1 : x1; x[8 + i] = rot ? y2 : x2; }
    u32x4 oa, ob;
#pragma unroll
    for (int j = 0; j < 4; ++j) { oa[j] = pk2(x[2 * j], x[2 * j + 1]); ob[j] = pk2(x[8 + 2 * j], x[8 + 2 * j + 1]); }
    u32x4* ptr = (u32x4*)((bf16_t*)(P.ws + WS_P) + (size_t)tok * NP + C_DAQ + 16 * lane);
    ptr[0] = oa; ptr[1] = ob;
}
__device__ __forceinline__ void da_prep_phase(const Params& P, int l, const int wid, const int bid, const int G) {
    const int tid = PHASE_TID(wid);
    const int lane = tid & 63, nw = blockDim.x >> 6;
    const float* g = (lane < 32 ? P.in[29] : P.in[30]) + l * 64 + 16 * (lane & 3);
    float gv[16];
    const float qs_ = lane < 32 ? 0.125f * 1.4426950408889634f : 1.0f;
#pragma unroll
    for (int j = 0; j < 16; ++j) gv[j] = g[j] * qs_;
    const int stride = G * nw; int tok = bid * nw + wid;
    DRaw RA, RB;
    if (tok < NTOK) da_load(RA, P, tok, lane);
#pragma unroll 1
    for (; tok < NTOK; tok += 2 * stride) {
        if (tok + stride < NTOK) da_load(RB, P, tok + stride, lane);
        da_proc(RA, P, tok, lane, gv);
        if (tok + stride < NTOK) {
            if (tok + 2 * stride < NTOK) da_load(RA, P, tok + 2 * stride, lane);
            da_proc(RB, P, tok + stride, lane, gv);
        }
    }
}

namespace att {
typedef short s16x4 __attribute__((ext_vector_type(4)));
typedef float f32x2_t __attribute__((ext_vector_type(2))); typedef __bf16 bf16x2_t __attribute__((ext_vector_type(2)));
__device__ __forceinline__ unsigned cvtpk(float lo, float hi) { f32x2_t v = {lo, hi}; bf16x2_t b = __builtin_convertvector(v, bf16x2_t); return __builtin_bit_cast(unsigned, b); }
__device__ __forceinline__ s16x4 vtr(LAS unsigned char* p) { return __builtin_bit_cast(s16x4, __builtin_amdgcn_ds_read_tr16_b64_v4i16((LAS s16x4*)p)); }
#define MFMA32(a, b, c) __builtin_amdgcn_mfma_f32_32x32x16_bf16((a), (b), (c), 0, 0, 0)
constexpr int VPITCH = 320;
constexpr int UNIT_OFF = 140 * 1024;

template <int DQK, bool NM>
__device__ __forceinline__ void flash_map(LAS unsigned char* lds, const bf16_t* Qp, int qpitch, const bf16_t* Kp, int kpitch, const bf16_t* Vp, int vpitch,
                                          size_t tokb, int q0, float sc, f32x16 (&o)[4], const int wid, const int tid) {
    constexpr int KP = DQK * 2 + 16, KBUF = 64 * KP, VBUF = 64 * VPITCH, CPR = DQK / 8, KCH = (64 * CPR) / 512, NKS = DQK / 16;
    const int lane = tid & 63, r32 = lane & 31, hh = lane >> 5;
    constexpr int NPF = DQK == 192 ? 2 : 4;
    constexpr int NKP = DQK == 192 ? 2 : 4;
    constexpr int NKR = DQK == 192 ? (NM ? 8 : 7) : NKS;
    constexpr int QL_OFF = 2 * (64 * (DQK * 2 + 16)) + 2 * (64 * VPITCH), QLP = 176;
    bf16x8 qf[NKR];
    LAS unsigned char* qlds = lds + QL_OFF + wid * (32 * QLP) + r32 * QLP + 16 * hh;
    { const bf16_t* qrow = Qp + (tokb + q0 + 32 * wid + r32) * qpitch + 8 * hh;
#pragma unroll
      for (int ks = 0; ks < NKS; ++ks) { const bf16x8 v = *(const bf16x8*)(qrow + 16 * ks); if (ks < NKR) qf[ks < NKR ? ks : 0] = v; else *(LAS bf16x8*)(qlds + 32 * (ks - NKR)) = v; } }
    const int nkt = (q0 + 256) / 64;
    u32x4 kr[KCH], vr[2];
    int koff[KCH], kl[KCH], voff[2], vl_[2];
#pragma unroll
    for (int i = 0; i < KCH; ++i) { const int c = tid + 512 * i, row = c / CPR, col = c % CPR; koff[i] = row * kpitch + col * 8; kl[i] = row * KP + col * 16; }
#pragma unroll
    for (int i = 0; i < 2; ++i) { const int c = tid + 512 * i, row = c >> 4, col = c & 15; voff[i] = row * vpitch + col * 8; vl_[i] = 2 * KBUF + row * VPITCH + col * 16; }
#define ATT_GLOADK(kt) do { const bf16_t* kt_ = Kp + (tokb + 64 * (kt)) * kpitch; \
        _Pragma("unroll") for (int i_ = 0; i_ < KCH; ++i_) kr[i_] = *(const u32x4*)(kt_ + koff[i_]); } while (0)
#define ATT_GLOADV(kt) do { const bf16_t* vt_ = Vp + (tokb + 64 * (kt)) * vpitch; \
        _Pragma("unroll") for (int i_ = 0; i_ < 2; ++i_) vr[i_] = *(const u32x4*)(vt_ + voff[i_]); } while (0)
#define ATT_LWRITEK(buf) do { _Pragma("unroll") for (int i_ = 0; i_ < KCH; ++i_) *(LAS u32x4*)(lds + (buf) * KBUF + kl[i_]) = kr[i_]; } while (0)
#define ATT_LWRITEV(buf) do { _Pragma("unroll") for (int i_ = 0; i_ < 2; ++i_) *(LAS u32x4*)(lds + (buf) * VBUF + vl_[i_]) = vr[i_]; } while (0)
    constexpr bool FOLD = DQK == 64 && !NM;
    float m_run = (FOLD || NM) ? 0.f : -INFINITY, l_run = 0.f;
    const bf16x8 kone_ = __builtin_bit_cast(bf16x8, (u32x4){(tid & 32) ? 0u : 0x3F80u, 0u, 0u, 0u});
    u32x4 qmw_ = {0u, 0u, 0u, 0u};
#pragma unroll
    for (int vb = 0; vb < 4; ++vb)
#pragma unroll
        for (int r = 0; r < 16; ++r) o[vb][r] = 0.f;
    { u32x4 k1_[KCH]; const bf16_t* kt1_ = Kp + (tokb + 64) * kpitch;
      ATT_GLOADK(0); ATT_GLOADV(0);
#pragma unroll
      for (int i = 0; i < KCH; ++i) k1_[i] = *(const u32x4*)(kt1_ + koff[i]);
      ATT_LWRITEK(0); ATT_LWRITEV(0);
#pragma unroll
      for (int i = 0; i < KCH; ++i) *(LAS u32x4*)(lds + KBUF + kl[i]) = k1_[i]; }
    if (nkt > 2) ATT_GLOADK(2);
    ATT_GLOADV(1);
    __syncthreads();
    const int qw0 = q0 + 32 * wid, qg = qw0 + r32;
    const int g16 = lane >> 4, i16 = lane & 15;
    const int vlane_off = ((i16 >> 2) + 4 * hh) * VPITCH + (16 * (g16 & 1) + 4 * (i16 & 3)) * 2;
#define ATT_QK(SV, kt_, kb_) do { LAS unsigned char* kbase_ = lds + ((kt_) & 1) * KBUF + (32 * (kb_) + r32) * KP + 16 * hh; \
        _Pragma("unroll") for (int r_ = 0; r_ < 16; ++r_) SV[r_] = 0.f; \
        bf16x8 ka_[NKP];     \
        _Pragma("unroll") for (int ks = 0; ks < NKP; ++ks) ka_[ks] = *(const LAS bf16x8*)(kbase_ + 32 * ks); \
        _Pragma("unroll") for (int ks = 0; ks < NKS; ++ks) { \
            const bf16x8 bq_ = ks < NKR ? qf[ks < NKR ? ks : 0] : *(const LAS bf16x8*)(qlds + 32 * (ks - NKR)); SV = MFMA32(ka_[ks % NKP], bq_, SV); \
            if (ks + NKP < NKS) ka_[ks % NKP] = *(const LAS bf16x8*)(kbase_ + 32 * (ks + NKP)); } \
        if (FOLD) SV = MFMA32(kone_, __builtin_bit_cast(bf16x8, qmw_), SV); } while (0)
#define ATT_EXP(SV, PF) do { float ps_ = 0.f; \
        _Pragma("unroll") for (int r_ = 0; r_ < 16; ++r_) { SV[r_] = (FOLD || NM) ? __builtin_amdgcn_exp2f(SV[r_]) : __builtin_amdgcn_exp2f(SV[r_] * sc - m_run); ps_ += SV[r_]; } \
        l_run += ps_; \
        _Pragma("unroll") for (int s2 = 0; s2 < 2; ++s2) { u32x4 w_; _Pragma("unroll") for (int j = 0; j < 4; ++j) w_[j] = cvtpk(SV[8 * s2 + 2 * j], SV[8 * s2 + 2 * j + 1]); PF[s2] = __builtin_bit_cast(bf16x8, w_); } } while (0)
#define ATT_PV(PF, kb_) do { LAS unsigned char* vbase_ = lds + 2 * KBUF + (kt & 1) * VBUF + vlane_off + (32 * (kb_)) * VPITCH; \
        bf16x8 vf_[NPF];     \
        _Pragma("unroll") for (int i_ = 0; i_ < NPF; ++i_) { const s16x4 lo_ = vtr(vbase_ + (16 * (i_ >> 2)) * VPITCH + 64 * (i_ & 3)), hi_ = vtr(vbase_ + (16 * (i_ >> 2) + 8) * VPITCH + 64 * (i_ & 3)); \
            vf_[i_] = __builtin_shufflevector(lo_, hi_, 0, 1, 2, 3, 4, 5, 6, 7); } \
        _Pragma("unroll") for (int i_ = 0; i_ < 8; ++i_) { \
            o[i_ & 3] = MFMA32(vf_[i_ % NPF], PF[i_ >> 2], o[i_ & 3]); \
            if (i_ + NPF < 8) { const int n_ = i_ + NPF; const s16x4 lo_ = vtr(vbase_ + (16 * (n_ >> 2)) * VPITCH + 64 * (n_ & 3)), hi_ = vtr(vbase_ + (16 * (n_ >> 2) + 8) * VPITCH + 64 * (n_ & 3)); \
                vf_[i_ % NPF] = __builtin_shufflevector(lo_, hi_, 0, 1, 2, 3, 4, 5, 6, 7); } } } while (0)
#define ATT_SETM() do { qmw_.x = hh == 0 ? (__float_as_uint(-m_run) >> 16) : 0u; } while (0)
#define ATT_RESCALE_F(mx_) do { if (__any((mx_) > 8.0f)) { const float m_new_ = __uint_as_float(__float_as_uint(m_run + fmaxf((mx_), 0.f)) & 0xffff0000u); const float dl_ = fmaxf(m_new_ - m_run, 0.f); \
            const float alpha_ = __builtin_amdgcn_exp2f(-dl_); m_run += dl_; l_run *= alpha_; ATT_SETM(); \
            _Pragma("unroll") for (int r_ = 0; r_ < 16; ++r_) { s0[r_] -= dl_; s1[r_] -= dl_; }     \
            _Pragma("unroll") for (int vb = 0; vb < 4; ++vb) _Pragma("unroll") for (int r_ = 0; r_ < 16; ++r_) o[vb][r_] *= alpha_; } } while (0)
#define ATT_RESCALE(mx_) do { if (__any((mx_) > m_run + 8.0f)) { const float m_new_ = fmaxf(m_run, (mx_)); const float alpha_ = __builtin_amdgcn_exp2f(m_run - m_new_); m_run = m_new_; l_run *= alpha_; \
            _Pragma("unroll") for (int vb = 0; vb < 4; ++vb) _Pragma("unroll") for (int r_ = 0; r_ < 16; ++r_) o[vb][r_] *= alpha_; } } while (0)
#define ATT_SMPV(SV, kb_) do { const int k0_ = 64 * kt + 32 * (kb_); float mx_ = -INFINITY; \
        if (k0_ + 31 > qw0) { _Pragma("unroll") for (int r_ = 0; r_ < 16; ++r_) { const int key_ = k0_ + (r_ & 3) + 8 * (r_ >> 2) + 4 * hh; SV[r_] = key_ > qg ? -INFINITY : SV[r_]; if (!NM) mx_ = fmaxf(mx_, SV[r_]); } } \
        else if (!NM) { _Pragma("unroll") for (int r_ = 0; r_ < 16; ++r_) mx_ = fmaxf(mx_, SV[r_]); } \
        if (!NM) { if (FOLD) { mx_ = xor32_max_fast(mx_); ATT_RESCALE_F(mx_); } else { mx_ = xor32_max_fast(mx_) * sc; ATT_RESCALE(mx_); } } \
        bf16x8 pf_[2]; ATT_EXP(SV, pf_); ATT_PV(pf_, kb_); } while (0)
    const int nfull = q0 >> 6;
    f32x16 s0, s1;
    ATT_QK(s0, 0, 0);
    if (!NM) { float mx_ = s0[0];
#pragma unroll
      for (int r = 1; r < 16; ++r) mx_ = fmaxf(mx_, s0[r]);
      if (FOLD) { mx_ = xor32_max_fast(mx_); m_run = __uint_as_float(__float_as_uint(mx_) & 0xffff0000u); ATT_SETM();
#pragma unroll
          for (int r = 0; r < 16; ++r) s0[r] -= m_run; }
      else { mx_ = xor32_max_fast(mx_) * sc; ATT_RESCALE(mx_); } }
#define ATT_E1(SC, r_) do { SC[r_] = (FOLD || NM) ? __builtin_amdgcn_exp2f(SC[r_]) : __builtin_amdgcn_exp2f(SC[r_] * sc - m_run); ps_ += SC[r_]; } while (0)
#define ATT_CV(SC, w_) (cvtpk(SC[2 * (w_)], SC[2 * (w_) + 1]))
#define ATT_STEP(SC, SN, ktn_, kbn_, kbv_, ktnn_, kbnn_) do { \
        LAS unsigned char* kbase_ = lds + ((ktn_) & 1) * KBUF + (32 * (kbn_) + r32) * KP + 16 * hh; \
        LAS unsigned char* knext_ = lds + ((ktnn_) & 1) * KBUF + (32 * (kbnn_) + r32) * KP + 16 * hh;     \
        LAS unsigned char* vbase_ = lds + 2 * KBUF + (kt & 1) * VBUF + vlane_off + (32 * (kbv_)) * VPITCH; \
        bf16x8 vf_[NPF]; u32x4 pw0_, pw1_; float ps_ = 0.f; \
        _Pragma("unroll") for (int r_ = 0; r_ < 16; ++r_) SN[r_] = 0.f; \
        __builtin_amdgcn_sched_barrier(0); \
        _Pragma("unroll") for (int ks = 0; ks < NKS; ++ks) { \
            const bf16x8 bq_ = ks < NKR ? qf[ks < NKR ? ks : 0] : *(const LAS bf16x8*)(qlds + 32 * (ks - NKR)); SN = MFMA32(ka_[ks % NKP], bq_, SN); \
            if (ks + NKP < NKS) ka_[ks % NKP] = *(const LAS bf16x8*)(kbase_ + 32 * (ks + NKP)); \
            if (NKS == 4) { ATT_E1(SC, 2 * ks); ATT_E1(SC, 2 * ks + 1); pw0_[ks] = ATT_CV(SC, ks); } \
            else { if (ks < 8) ATT_E1(SC, ks < 8 ? ks : 0); else pw0_[ks < 8 ? 0 : ks - 8] = ATT_CV(SC, ks < 8 ? 0 : ks - 8); } \
            if (ks >= NKS - (NPF / 2) ) { _Pragma("unroll") for (int i_ = 2 * (ks - (NKS - NPF / 2)); i_ < 2 * (ks - (NKS - NPF / 2)) + 2; ++i_) { \
                const s16x4 lo_ = vtr(vbase_ + (16 * (i_ >> 2)) * VPITCH + 64 * (i_ & 3)), hi_ = vtr(vbase_ + (16 * (i_ >> 2) + 8) * VPITCH + 64 * (i_ & 3)); \
                vf_[i_] = __builtin_shufflevector(lo_, hi_, 0, 1, 2, 3, 4, 5, 6, 7); } } \
            __builtin_amdgcn_sched_barrier(0); } \
        if (FOLD) { SN = MFMA32(kone_, __builtin_bit_cast(bf16x8, qmw_), SN); __builtin_amdgcn_sched_barrier(0); } \
        float mxn_ = SN[0]; \
        _Pragma("unroll") for (int i_ = 0; i_ < 8; ++i_) { \
            o[i_ & 3] = MFMA32(vf_[i_ % NPF], __builtin_bit_cast(bf16x8, i_ < 4 ? pw0_ : pw1_), o[i_ & 3]); \
            if (i_ + NPF < 8) { const int n_ = i_ + NPF; const s16x4 lo_ = vtr(vbase_ + (16 * (n_ >> 2)) * VPITCH + 64 * (n_ & 3)), hi_ = vtr(vbase_ + (16 * (n_ >> 2) + 8) * VPITCH + 64 * (n_ & 3)); \
                vf_[i_ % NPF] = __builtin_shufflevector(lo_, hi_, 0, 1, 2, 3, 4, 5, 6, 7); } \
            if (i_ < 4) { ATT_E1(SC, 8 + 2 * (i_ & 3)); ATT_E1(SC, 9 + 2 * (i_ & 3)); pw1_[i_ & 3] = ATT_CV(SC, 4 + (i_ & 3)); } \
            else { const int b_ = 4 * (i_ & 3); if (!NM) mxn_ = fmaxf(fmaxf(mxn_, SN[b_ + (b_ == 0 ? 1 : 0)]), fmaxf(SN[b_ + 1], fmaxf(SN[b_ + 2], SN[b_ + 3]))); \
                   if ((i_ & 3) < NKP) ka_[i_ & 3] = *(const LAS bf16x8*)(knext_ + 32 * (i_ & 3)); } \
            __builtin_amdgcn_sched_barrier(0); } \
        l_run += ps_; \
        if (!NM) { if (FOLD) { mxn_ = xor32_max_fast(mxn_); ATT_RESCALE_F(mxn_); } else { mxn_ = xor32_max_fast(mxn_) * sc; ATT_RESCALE(mxn_); } } } while (0)
    int kt = 0;
    bf16x8 ka_[NKP];
    if (nfull > 0) { LAS unsigned char* kb0_ = lds + (32 + r32) * KP + 16 * hh;
#pragma unroll
        for (int ks = 0; ks < NKP; ++ks) ka_[ks] = *(const LAS bf16x8*)(kb0_ + 32 * ks); }
#pragma unroll 1
    for (; kt < nfull; ++kt) {
        if (kt + 1 < nkt) { ATT_LWRITEV((kt + 1) & 1); if (kt + 2 < nkt) ATT_GLOADV(kt + 2); }
        ATT_STEP(s0, s1, kt, 1, 0, kt + 1, 0);
        LDS_BARRIER();
        if (kt + 2 < nkt) { ATT_LWRITEK(kt & 1); if (kt + 3 < nkt) ATT_GLOADK(kt + 3); }
        ATT_STEP(s1, s0, kt + 1, 0, 1, kt + 1, 1);
        LDS_BARRIER();
    }
#pragma unroll 1
    for (; kt < nkt; ++kt) {
        if (kt + 1 < nkt) { ATT_LWRITEV((kt + 1) & 1); if (kt + 2 < nkt) ATT_GLOADV(kt + 2); }
        const bool do0 = 64 * kt <= qw0 + 31, do1 = 64 * kt + 32 <= qw0 + 31;
        if (do1) ATT_QK(s1, kt, 1);
        if (do0) ATT_SMPV(s0, 0);
        LDS_BARRIER();
        if (kt + 2 < nkt) { ATT_LWRITEK(kt & 1); if (kt + 3 < nkt) ATT_GLOADK(kt + 3); }
        if (kt + 1 < nkt && 64 * (kt + 1) <= qw0 + 31) ATT_QK(s0, kt + 1, 0);
        if (do1) ATT_SMPV(s1, 1);
        LDS_BARRIER();
    }
#undef ATT_STEP
#undef ATT_E1
#undef ATT_CV
#undef ATT_EXP
#undef ATT_PV
#undef ATT_RESCALE
#undef ATT_RESCALE_F
#undef ATT_SETM
#undef ATT_QK
#undef ATT_SMPV
#undef ATT_GLOADK
#undef ATT_GLOADV
#undef ATT_LWRITEK
#undef ATT_LWRITEV
    l_run = xor32_sum(l_run);
    const float il = 1.0f / l_run;
#pragma unroll
    for (int vb = 0; vb < 4; ++vb)
#pragma unroll
        for (int r = 0; r < 16; ++r) o[vb][r] *= il;
}

template <bool NM>
__device__ __forceinline__ void attn_phase(const Params& P, int l, LAS unsigned char* lds, unsigned* counter, const int wid) {
    const float LOG2E = 1.4426950408889634f;
    const bf16_t* p = (const bf16_t*)(P.ws + WS_P); bf16_t* y = (bf16_t*)(P.ws + WS_XB);
    const float beta = P.in[4][l * 4 + 2];
    float d1 = 0.f, d2 = 0.f;
    for (int i = 0; i < 64; ++i) { d1 += P.in[31][l * 64 + i] * P.in[32][l * 64 + i]; d2 += P.in[33][l * 64 + i] * P.in[34][l * 64 + i]; }
    const float lam_init = 0.8f - 0.6f * expf(-0.3f * (float)l); const float lam = expf(d1) - expf(d2) + lam_init;
    const float post = (1.0f - lam_init) * P.in[4][l * 4 + 3];
    const float* sg = P.in[35] + l * 128;
#define ATT_SGPRF(x) __builtin_bit_cast(float, __builtin_amdgcn_readfirstlane(__builtin_bit_cast(int, (x))))
    const float beta_s = ATT_SGPRF(beta), lam_s = ATT_SGPRF(lam), post_s = ATT_SGPRF(post);
#undef ATT_SGPRF
    const unsigned long long T0 = 0xda78aef97f635cfull, T1 = 0x1d4962dcd8c9f48ull, T2 = 0x8022190a74ull;
    for (;;) {
        { const int tid0 = PHASE_TID(wid); unsigned* c_ = counter; OPAQUE_S(c_); if (tid0 == 0) *(LAS unsigned*)(lds + UNIT_OFF) = atomicAdd(c_, 1u); }
        __syncthreads();
        const unsigned u = (unsigned)__builtin_amdgcn_readfirstlane((int)*(LAS unsigned*)(lds + UNIT_OFF));
        __syncthreads();
        if (u >= 512u) break;
        const unsigned r = u >> 4; const unsigned e = (unsigned)((r < 12u ? T0 >> (5u * r) : (r < 24u ? T1 >> (5u * (r - 12u)) : T2 >> (5u * (r - 24u)))) & 31ull);
        const int qb = (int)(e & 15u), bh = u & 15, b = bh >> 2, h = bh & 3, q0 = qb * 256;
        const size_t tokb = (size_t)b * TT;
        if (e & 16u) {
            const int tid = PHASE_TID(wid);
            f32x16 o[4];
            flash_map<192, NM>(lds, (const bf16_t*)(P.ws + WS_QRAW) + 192 * h, 768, (const bf16_t*)(P.ws + WS_KMLA) + 192 * h, 768, (const bf16_t*)(P.ws + WS_KVRAW) + 256 * h + 128, 1024, tokb, q0, 1.0f, o, wid, tid);
            const int lane = lane_id_opaque(), r32 = lane & 31, hh = lane >> 5;
            const size_t tok = tokb + q0 + 32 * wid + r32;
            const bf16_t* zr = p + tok * NP + C_Z + Y_MLA + 128 * h; bf16_t* yr = y + tok * DM + Y_MLA + 128 * h;
#pragma unroll
            for (int vb = 0; vb < 4; ++vb)
#pragma unroll
                for (int g = 0; g < 4; ++g) { const int vd = 32 * vb + 8 * g + 4 * hh; const u32x2 zz = *(const u32x2*)(zr + vd);
                    const float z0 = __uint_as_float(zz.x << 16), z1 = __uint_as_float(zz.x & 0xffff0000u), z2 = __uint_as_float(zz.y << 16), z3 = __uint_as_float(zz.y & 0xffff0000u);
                    u32x2 w; w.x = pk2(beta_s * o[vb][4 * g] * (z0 / (1.0f + __expf(-z0))), beta_s * o[vb][4 * g + 1] * (z1 / (1.0f + __expf(-z1))));
                    w.y = pk2(beta_s * o[vb][4 * g + 2] * (z2 / (1.0f + __expf(-z2))), beta_s * o[vb][4 * g + 3] * (z3 / (1.0f + __expf(-z3))));
                    *(u32x2*)(yr + vd) = w; }
        } else {
            const int tid = PHASE_TID(wid);
            f32x16 o[4];
            flash_map<64, NM>(lds, p + C_DAQ + 128 * h, NP, p + C_DAK + 128 * h, NP, p + C_DAV + 128 * h, NP, tokb, q0, 0.125f * LOG2E, o, wid, tid);
            const int lane = lane_id_opaque(), r32 = lane & 31, hh = lane >> 5;
            LAS unsigned* stash = (LAS unsigned*)(lds + 61440) + wid * 2048 + lane;
#pragma unroll
            for (int vb = 0; vb < 4; ++vb)
#pragma unroll
                for (int j = 0; j < 8; ++j) stash[(vb * 8 + j) * 64] = cvtpk(o[vb][2 * j], o[vb][2 * j + 1]);
            flash_map<64, NM>(lds, p + C_DAQ + 128 * h + 64, NP, p + C_DAK + 128 * h + 64, NP, p + C_DAV + 128 * h, NP, tokb, q0, 0.125f * LOG2E, o, wid, tid);
            float ss = 0.f;
#pragma unroll
            for (int vb = 0; vb < 4; ++vb)
#pragma unroll
                for (int j = 0; j < 8; ++j) { const unsigned w = stash[(vb * 8 + j) * 64];
                    o[vb][2 * j] = __uint_as_float(w << 16) - lam_s * o[vb][2 * j]; o[vb][2 * j + 1] = __uint_as_float(w & 0xffff0000u) - lam_s * o[vb][2 * j + 1];
                    ss += o[vb][2 * j] * o[vb][2 * j] + o[vb][2 * j + 1] * o[vb][2 * j + 1]; }
            ss = xor32_sum(ss);
            const float rs = rsqrtf(ss * (1.0f / 128.f) + 1e-6f) * post_s;
            const size_t tok = tokb + q0 + 32 * wid + r32;
            const bf16_t* zr = p + tok * NP + C_Z + Y_DA + 128 * h; bf16_t* yr = y + tok * DM + Y_DA + 128 * h;
#pragma unroll
            for (int vb = 0; vb < 4; ++vb)
#pragma unroll
                for (int g = 0; g < 4; ++g) { const int vd = 32 * vb + 8 * g + 4 * hh; const u32x2 zz = *(const u32x2*)(zr + vd); const f32x4 gg = *(const f32x4*)(sg + vd);
                    const float z0 = __uint_as_float(zz.x << 16), z1 = __uint_as_float(zz.x & 0xffff0000u), z2 = __uint_as_float(zz.y << 16), z3 = __uint_as_float(zz.y & 0xffff0000u);
                    u32x2 w; w.x = pk2(rs * gg[0] * o[vb][4 * g] * (z0 / (1.0f + __expf(-z0))), rs * gg[1] * o[vb][4 * g + 1] * (z1 / (1.0f + __expf(-z1))));
                    w.y = pk2(rs * gg[2] * o[vb][4 * g + 2] * (z2 / (1.0f + __expf(-z2))), rs * gg[3] * o[vb][4 * g + 3] * (z3 / (1.0f + __expf(-z3))));
                    *(u32x2*)(yr + vd) = w; }
        }
    }
}
}

namespace wkv {
constexpr int BUF = 6 * 8192;
constexpr int O_W = 0, O_NKK = 8192, O_KKA = 16384, O_KP = 24576, O_R = 32768, O_V = 40960;
constexpr int O_YB = 2 * BUF, O_BON = O_YB + 8192, O_LORA = O_BON + 256, O_MU = O_LORA + 3 * 4096, O_CST = O_MU + 256, O_DSC = O_CST + 9 * 256, O_END = O_DSC + 4 * 3 * 8 * 64 * 4;
static_assert(O_END <= 147456 - 16, "wkv LDS map");
__device__ __forceinline__ float dppf(float v, const int sel) {
    const int x = __builtin_bit_cast(int, v); int r;
    if (sel == 0) r = __builtin_amdgcn_update_dpp(0, x, 0xB1, 0xF, 0xF, true);
    else if (sel == 1) r = __builtin_amdgcn_update_dpp(0, x, 0x4E, 0xF, 0xF, true);
    else if (sel == 2) r = __builtin_amdgcn_update_dpp(0, x, 0x141, 0xF, 0xF, true);
    else r = __builtin_amdgcn_update_dpp(0, x, 0x140, 0xF, 0xF, true);
    return __builtin_bit_cast(float, r);
}
__device__ __forceinline__ float red8(float v) { v += dppf(v, 0); v += dppf(v, 1); v += dppf(v, 2); return v; }
__device__ __forceinline__ float wsum(float v) {
    v += dppf(v, 0); v += dppf(v, 1); v += dppf(v, 2); v += dppf(v, 3);
    const int x = __builtin_bit_cast(int, v);
    const float s0 = __builtin_bit_cast(float, __builtin_amdgcn_readlane(x, 0)), s1 = __builtin_bit_cast(float, __builtin_amdgcn_readlane(x, 16));
    const float s2 = __builtin_bit_cast(float, __builtin_amdgcn_readlane(x, 32)), s3 = __builtin_bit_cast(float, __builtin_amdgcn_readlane(x, 48));
    return (s0 + s1) + (s2 + s3);
}
__device__ __forceinline__ float fsig(float x) { return __builtin_amdgcn_rcpf(1.0f + __expf(-x)); }
typedef float f32x2 __attribute__((ext_vector_type(2)));
#define V2LO(x) __builtin_shufflevector(x, x, 0, 1)
#define V2HI(x) __builtin_shufflevector(x, x, 2, 3)
struct Ops { f32x4 w, n, a, k, r; float vv; };
__device__ __forceinline__ void load_ops(Ops& o, LAS unsigned char* bk, LAS unsigned char* bv, int tt) {
    const int off = tt * 256;
    o.w = *(const LAS f32x4*)(bk + O_W + off); o.n = *(const LAS f32x4*)(bk + O_NKK + off); o.a = *(const LAS f32x4*)(bk + O_KKA + off);
    o.k = *(const LAS f32x4*)(bk + O_KP + off); o.r = *(const LAS f32x4*)(bk + O_R + off);
    o.vv = *(const LAS float*)(bv + off);
}
__device__ __forceinline__ float red16(float v) { v += dppf(v, 0); v += dppf(v, 1); v += dppf(v, 2); v += dppf(v, 3); return v; }
__device__ __forceinline__ void step(const Ops& o, const f32x4 rprev, f32x2 (&S)[2], LAS float* by, int tt) {
    f32x2 p = S[0] * V2LO(o.n); p = S[1] * V2HI(o.n) + p;
    f32x2 u = S[0] * V2LO(rprev); u = S[1] * V2HI(rprev) + u;
    float sa = p.x + p.y, yv = u.x + u.y;
    sa += dppf(sa, 0); yv += dppf(yv, 0); sa += dppf(sa, 1); yv += dppf(yv, 1); sa += dppf(sa, 2); yv += dppf(yv, 2); sa += dppf(sa, 3); yv += dppf(yv, 3);
    const f32x2 sav = {sa, sa}, vvv = {o.vv, o.vv};
    S[0] = S[0] * V2LO(o.w) + (sav * V2LO(o.a) + vvv * V2LO(o.k));
    S[1] = S[1] * V2HI(o.w) + (sav * V2HI(o.a) + vvv * V2HI(o.k));
    if (tt > 0) by[(tt - 1) * 16] = yv;
}

struct HRaw { u32x4 rc, kc, vc, rp, kp, vp, vf; u32x4 wd[2], ad[2], vlp[2]; };
__device__ __forceinline__ void h_load(HRaw& R, const Params& P, const int b, const int h, const int hw, const int lane, const int cc) {
    const bf16_t* p = (const bf16_t*)(P.ws + WS_P); const bf16_t* vfirst = (const bf16_t*)(P.ws + WS_VFIRST);
    const int hh = lane >> 5, c32 = lane & 31, tt = lane >> 3, cg = lane & 7, t0 = cc * 32 + 8 * hw; const size_t tokb = (size_t)b * TT + t0;
    const bf16_t* row = p + (tokb + tt) * NP + 64 * h + 8 * cg;
    const int pm = (t0 + tt) > 0 ? NP : 0;
    R.rc = *(const u32x4*)(row + C_RWR); R.kc = *(const u32x4*)(row + C_RWK); R.vc = *(const u32x4*)(row + C_RWV);
    R.rp = *(const u32x4*)(row - pm + C_RWR); R.kp = *(const u32x4*)(row - pm + C_RWK); R.vp = *(const u32x4*)(row - pm + C_RWV);
    R.vf = *(const u32x4*)(vfirst + (tokb + tt) * 512 + 64 * h + 8 * cg);
    const int lrw = c32 < 9 ? c32 : 0; const int tprev = (int)t0 - 1 + lrw; const bf16_t* lrow = p + ((size_t)b * TT + (tprev < 0 ? 0 : tprev)) * NP + C_RWWD + 8 * hh;
    const int lr = c32 < 8 ? c32 : 0; const bf16_t* vlb = (const bf16_t*)(P.ws + WS_VL);
#pragma unroll
    for (int ks = 0; ks < 2; ++ks) {
        R.wd[ks] = *(const u32x4*)(lrow + 16 * ks); R.ad[ks] = *(const u32x4*)(lrow + 32 + 16 * ks);
        R.vlp[ks] = *(const u32x4*)(vlb + (tokb + lr) * 32 + 16 * ks + 8 * hh);
    }
}
__device__ __forceinline__ bf16x8 shift_pack(const u32x4 c, const u32x4 q, const LAS float* mu8, const float zprev, const float valid, const bool do_tanh) {
    const f32x4 m0 = *(const LAS f32x4*)mu8, m1 = *(const LAS f32x4*)(mu8 + 4); u32x4 w;
#pragma unroll
    for (int j = 0; j < 4; ++j) {
        const float c0 = blo(c[j]), c1 = bhi(c[j]), q0 = blo(q[j]) * zprev, q1 = bhi(q[j]) * zprev;
        const float ma = j < 2 ? m0[2 * j] : m1[2 * j - 4], mb = j < 2 ? m0[2 * j + 1] : m1[2 * j - 3];
        float x0 = c0 + (q0 - c0) * ma, x1 = c1 + (q1 - c1) * mb;
        if (do_tanh) { x0 = 1.0f - 2.0f * __builtin_amdgcn_rcpf(1.0f + __expf(2.0f * x0)); x1 = 1.0f - 2.0f * __builtin_amdgcn_rcpf(1.0f + __expf(2.0f * x1)); }
        w[j] = att::cvtpk(x0 * valid, x1 * valid);
    }
    return __builtin_bit_cast(bf16x8, w);
}
__device__ __forceinline__ void ld8(float (&o)[8], const LAS float* p) { const f32x4 a = *(const LAS f32x4*)p, b = *(const LAS f32x4*)(p + 4);
#pragma unroll
    for (int j = 0; j < 4; ++j) { o[j] = a[j]; o[4 + j] = b[j]; } }
__device__ __forceinline__ void st8(LAS float* p, const float (&v)[8]) { *(LAS f32x4*)p = (f32x4){v[0], v[1], v[2], v[3]}; *(LAS f32x4*)(p + 4) = (f32x4){v[4], v[5], v[6], v[7]}; }
__device__ __forceinline__ void unp8(float (&o)[8], const u32x4 w) {
#pragma unroll
    for (int j = 0; j < 4; ++j) { o[2 * j] = blo(w[j]); o[2 * j + 1] = bhi(w[j]); } }
__device__ __forceinline__ void h_prep(const HRaw& R, const Params& P, const int l, const int b, const int h, const int rh, LAS unsigned char* lds, const int hw, const int lane, const int cc) {
    const int hh = lane >> 5, c32 = lane & 31, tt = lane >> 3, cg = lane & 7, t0 = cc * 32 + 8 * hw; const size_t tokb = (size_t)b * TT + t0;
    LAS unsigned char* buf = lds + (cc & 1) * BUF;
    const LAS float* mu = (const LAS float*)(lds + O_MU) - 1536;
    const LAS float* cst = (const LAS float*)(lds + O_CST) + 8 * cg;
    LAS float* dsc = (LAS float*)(lds + O_DSC) + hw * (3 * 8 * 64);
    const float valid = c32 < 8 ? 1.0f : 0.0f; const float zprev = (t0 + (c32 < 8 ? c32 : 0)) > 0 ? 1.0f : 0.0f;
    {
        const LAS unsigned char* tab = lds + O_LORA + (c32 * 32 + 8 * hh) * 2;
#define LORA_ONE(LI, A0, A1) do { \
            _Pragma("unroll") for (int tl = 0; tl < 2; ++tl) { f32x16 acc_; _Pragma("unroll") for (int r = 0; r < 16; ++r) acc_[r] = 0.f; \
                acc_ = MFMA32(A0, *(const LAS bf16x8*)(tab + ((LI) * 64 + 32 * tl) * 64), acc_); acc_ = MFMA32(A1, *(const LAS bf16x8*)(tab + ((LI) * 64 + 32 * tl) * 64 + 32), acc_); \
                _Pragma("unroll") for (int i = 0; i < 4; ++i) dsc[((LI) * 8 + 4 * hh + i) * 64 + c32 + 32 * tl] = acc_[i]; } \
            __builtin_amdgcn_sched_barrier(0); } while (0)
#define SHL1(x) ((unsigned)__builtin_amdgcn_update_dpp(0, (int)(x), 0x101, 0xF, 0xF, true))
        { u32x4 c0, c1;
#pragma unroll
          for (int j = 0; j < 4; ++j) { c0[j] = SHL1(R.wd[0][j]); c1[j] = SHL1(R.wd[1][j]); }
          const bf16x8 A0 = shift_pack(c0, R.wd[0], mu + 1536 + 8 * hh, zprev, valid, true), A1 = shift_pack(c1, R.wd[1], mu + 1536 + 16 + 8 * hh, zprev, valid, true);
          LORA_ONE(0, A0, A1); }
        { u32x4 c0, c1;
#pragma unroll
          for (int j = 0; j < 4; ++j) { c0[j] = SHL1(R.ad[0][j]); c1[j] = SHL1(R.ad[1][j]); }
          const bf16x8 A0 = shift_pack(c0, R.ad[0], mu + 1568 + 8 * hh, zprev, valid, false), A1 = shift_pack(c1, R.ad[1], mu + 1568 + 16 + 8 * hh, zprev, valid, false);
          LORA_ONE(1, A0, A1); }
        if (l) { u32x4 v0 = R.vlp[0], v1 = R.vlp[1];
          if (c32 >= 8) { v0 = (u32x4){0u, 0u, 0u, 0u}; v1 = v0; }
          LORA_ONE(2, __builtin_bit_cast(bf16x8, v0), __builtin_bit_cast(bf16x8, v1)); }
#undef SHL1
#undef LORA_ONE
    }
    LDS_WAIT();
    const float pz = (t0 + tt) > 0 ? 1.0f : 0.0f;
    float rr[8], kx[8], vx[8], t8[8], c8[8];
    { float pv[8]; unp8(rr, R.rc); unp8(pv, R.rp); ld8(c8, cst + 6 * 64);
#pragma unroll
      for (int j = 0; j < 8; ++j) rr[j] += (pv[j] * pz - rr[j]) * c8[j];
      unp8(kx, R.kc); unp8(pv, R.kp); ld8(c8, cst + 7 * 64);
#pragma unroll
      for (int j = 0; j < 8; ++j) kx[j] += (pv[j] * pz - kx[j]) * c8[j];
      unp8(vx, R.vc); unp8(pv, R.vp); ld8(c8, cst + 8 * 64);
#pragma unroll
      for (int j = 0; j < 8; ++j) vx[j] += (pv[j] * pz - vx[j]) * c8[j]; }
    float dec[8], aa[8];
    ld8(t8, dsc + (0 * 8 + tt) * 64 + 8 * cg); ld8(c8, cst + 0 * 64);
#pragma unroll
    for (int j = 0; j < 8; ++j) { const float wp = c8[j] + t8[j];
        dec[j] = __builtin_amdgcn_exp2f(-0.8750387749145392f * __builtin_amdgcn_rcpf(1.0f + __builtin_amdgcn_exp2f(-1.4426950408889634f * wp))); }
    ld8(t8, dsc + (1 * 8 + tt) * 64 + 8 * cg); ld8(c8, cst + 1 * 64);
#pragma unroll
    for (int j = 0; j < 8; ++j) aa[j] = fsig(c8[j] + t8[j]);
    if (l == 0) { if (rh == 0) { u32x4 w;
#pragma unroll
        for (int j = 0; j < 4; ++j) w[j] = pk2(vx[2 * j], vx[2 * j + 1]);
        *(u32x4*)((bf16_t*)(P.ws + WS_VFIRST) + (tokb + tt) * 512 + 64 * h + 8 * cg) = w; } }
    if (l) { float vf8[8]; unp8(vf8, R.vf); ld8(t8, dsc + (2 * 8 + tt) * 64 + 8 * cg); ld8(c8, cst + 2 * 64);
#pragma unroll
      for (int j = 0; j < 8; ++j) vx[j] += (vf8[j] - vx[j]) * fsig(c8[j] + t8[j]); }
    float kk[8], kp[8]; float n2p = 0.f, bop = 0.f;
    ld8(c8, cst + 3 * 64);
#pragma unroll
    for (int j = 0; j < 8; ++j) { kk[j] = kx[j] * c8[j]; n2p += kk[j] * kk[j]; }
    ld8(c8, cst + 4 * 64);
#pragma unroll
    for (int j = 0; j < 8; ++j) kp[j] = kx[j] * (1.f + (aa[j] - 1.f) * c8[j]);
    ld8(c8, cst + 5 * 64);
#pragma unroll
    for (int j = 0; j < 8; ++j) bop += rr[j] * kp[j] * c8[j];
    const float n2 = red8(n2p), bon = red8(bop);
    const float inv = __builtin_amdgcn_rsqf(fmaxf(n2, 1e-24f));
    const int ttc = 8 * hw + tt; LAS float* ob = (LAS float*)buf + ttc * 64 + 8 * cg;
    st8(ob + O_W / 4, dec); st8(ob + O_KP / 4, kp); st8(ob + O_R / 4, rr); st8(ob + O_V / 4, vx);
#pragma unroll
    for (int j = 0; j < 8; ++j) { kk[j] *= inv; aa[j] *= kk[j]; kk[j] = -kk[j]; }
    st8(ob + O_NKK / 4, kk); st8(ob + O_KKA / 4, aa);
    if (cg == 0) *(LAS float*)(lds + O_BON + ((cc & 1) * 32 + ttc) * 4) = bon;
}

__device__ __forceinline__ void unit(const Params& P, int l, int b, int h, int rh, LAS unsigned char* lds, const int wid) {
    const int tid = PHASE_TID(wid);
    const int lane = tid & 63;
    constexpr int NCH = TT / 32;
    if (wid < 4) {
        f32x2 S[2];
#pragma unroll
        for (int j = 0; j < 2; ++j) S[j] = (f32x2){0.f, 0.f};
        const int srow = 4 * wid + (lane >> 4), kq = lane & 15, vrow = 16 * rh + srow;
        __builtin_amdgcn_s_setprio(3);
        LDS_BARRIER();
        LDS_BARRIER();
#pragma unroll 1
        for (int c = 0; c < NCH; ++c) {
            LAS unsigned char* bk = lds + (c & 1) * BUF + 16 * kq; LAS unsigned char* bv = lds + (c & 1) * BUF + O_V + 4 * vrow; LAS float* by = (LAS float*)(lds + O_YB + (c & 1) * 2048) + srow;
            Ops A, B;
            load_ops(A, bk, bv, 0);
            f32x4 rp = A.r;
#pragma unroll
            for (int tt = 0; tt < 32; tt += 2) {
                load_ops(B, bk, bv, tt + 1);
                step(A, rp, S, by, tt); rp = A.r;
                if (tt + 2 < 32) load_ops(A, bk, bv, tt + 2);
                step(B, rp, S, by, tt + 1); rp = B.r;
            }
            { f32x2 u = S[0] * V2LO(rp); u = S[1] * V2HI(rp) + u; const float yv = red16(u.x + u.y); by[31 * 16] = yv; }
            LDS_BARRIER();
        }
        __builtin_amdgcn_s_setprio(0);
    } else {
        const int hw = wid - 4;
        bf16_t* y = (bf16_t*)(P.ws + WS_XB); bf16_t* bvb = (bf16_t*)(P.ws + WS_BV);
        { LAS bf16_t* tab = (LAS bf16_t*)(lds + O_LORA);
          for (int e = hw * 64 + lane; e < 64 * 32; e += 256) { const int cc_ = e >> 5, j = e & 31;
              tab[e] = (bf16_t)f2bf(P.in[7][(l * 32 + j) * 512 + 64 * h + cc_]); tab[2048 + e] = (bf16_t)f2bf(P.in[9][(l * 32 + j) * 512 + 64 * h + cc_]);
              tab[4096 + e] = (bf16_t)f2bf(l ? P.in[12][j * 512 + 64 * h + cc_] : 0.f); }
          const int ch = 64 * h + lane; const float* mu = P.in[5] + l * 1600; LAS float* cst = (LAS float*)(lds + O_CST);
          if (hw == 0) { ((LAS float*)(lds + O_MU))[lane] = mu[1536 + lane]; cst[0 * 64 + lane] = P.in[6][l * 512 + ch]; cst[1 * 64 + lane] = P.in[8][l * 512 + ch]; cst[2 * 64 + lane] = l ? P.in[10][ch] : 0.f; }
          if (hw == 1) { cst[3 * 64 + lane] = P.in[13][l * 512 + ch]; cst[4 * 64 + lane] = P.in[14][l * 512 + ch]; cst[5 * 64 + lane] = P.in[15][l * 512 + ch]; }
          if (hw == 2) { cst[6 * 64 + lane] = mu[ch]; cst[7 * 64 + lane] = mu[512 + ch]; cst[8 * 64 + lane] = mu[1024 + ch]; } }
        HRaw RA, RB;
#define WKV_OUT(cc) do { if (lane < 16) { const LAS float* buf_ = (const LAS float*)(lds + ((cc) & 1) * BUF); const LAS float* yb_ = (const LAS float*)(lds + O_YB + ((cc) & 1) * 2048); \
            const int tt_ = 8 * hw + (lane >> 1), r0_ = 8 * (lane & 1); float y8_[8], v8_[8]; ld8(y8_, yb_ + tt_ * 16 + r0_); ld8(v8_, buf_ + O_V / 4 + tt_ * 64 + 16 * rh + r0_); \
            const float bo_ = *(const LAS float*)(lds + O_BON + (((cc) & 1) * 32 + tt_) * 4); const size_t tok_ = (size_t)b * TT + (cc) * 32 + tt_; u32x4 wy_, wb_; \
            _Pragma("unroll") for (int j_ = 0; j_ < 4; ++j_) { wy_[j_] = pk2(y8_[2 * j_], y8_[2 * j_ + 1]); wb_[j_] = pk2(bo_ * v8_[2 * j_], bo_ * v8_[2 * j_ + 1]); } \
            *(u32x4*)(y + tok_ * DM + Y_RW + 64 * h + 16 * rh + r0_) = wy_; *(u32x4*)(bvb + tok_ * 512 + 64 * h + 16 * rh + r0_) = wb_; } } while (0)
        h_load(RA, P, b, h, hw, lane, 0);
        h_load(RB, P, b, h, hw, lane, 1);
        LDS_BARRIER();
        h_prep(RA, P, l, b, h, rh, lds, hw, lane, 0);
        LDS_BARRIER();
#pragma unroll 1
        for (int c = 0; c < NCH; c += 2) {
            if (c > 0) WKV_OUT(c - 1);
            if (c + 2 < NCH) h_load(RA, P, b, h, hw, lane, c + 2);
            h_prep(RB, P, l, b, h, rh, lds, hw, lane, c + 1);
            LDS_BARRIER();
            WKV_OUT(c);
            if (c + 3 < NCH) h_load(RB, P, b, h, hw, lane, c + 3);
            if (c + 2 < NCH) h_prep(RA, P, l, b, h, rh, lds, hw, lane, c + 2);
            LDS_BARRIER();
        }
        WKV_OUT(NCH - 1);
#undef WKV_OUT
    }
}

__device__ __forceinline__ void post_phase(const Params& P, int l, const int wid) {
    const int tid = PHASE_TID(wid);
    const int lane = tid & 63, nw = blockDim.x >> 6;
    const bf16_t* p = (const bf16_t*)(P.ws + WS_P); bf16_t* y = (bf16_t*)(P.ws + WS_XB); const bf16_t* bvb = (const bf16_t*)(P.ws + WS_BV);
    const float beta = P.in[4][l * 4 + 0];
    float lw[8], lb[8];
#pragma unroll
    for (int j = 0; j < 8; ++j) { lw[j] = P.in[16][l * 512 + 8 * lane + j]; lb[j] = P.in[17][l * 512 + 8 * lane + j]; }
    for (int tok = blockIdx.x * nw + wid; tok < NTOK; tok += gridDim.x * nw) {
        u32x4* yp = (u32x4*)(y + (size_t)tok * DM + Y_RW + 8 * lane);
        const u32x4 yy = *yp, bb = *(const u32x4*)(bvb + (size_t)tok * 512 + 8 * lane), zz = *(const u32x4*)(p + (size_t)tok * NP + C_Z + Y_RW + 8 * lane);
        float v[8]; float sm = 0.f;
#pragma unroll
        for (int j = 0; j < 4; ++j) { v[2 * j] = blo(yy[j]); v[2 * j + 1] = bhi(yy[j]); sm += v[2 * j] + v[2 * j + 1]; }
        const float mean = red8(sm) * (1.0f / 64.f); float sq = 0.f;
#pragma unroll
        for (int j = 0; j < 8; ++j) { v[j] -= mean; sq += v[j] * v[j]; }
        const float rs = rsqrtf(red8(sq) * (1.0f / 64.f) + 64e-5f);
        u32x4 o;
#pragma unroll
        for (int j = 0; j < 4; ++j) { const float z0 = blo(zz[j]), z1 = bhi(zz[j]);
            const float o0 = v[2 * j] * rs * lw[2 * j] + lb[2 * j] + blo(bb[j]), o1 = v[2 * j + 1] * rs * lw[2 * j + 1] + lb[2 * j + 1] + bhi(bb[j]);
            o[j] = pk2(beta * o0 * (z0 / (1.0f + __expf(-z0))), beta * o1 * (z1 / (1.0f + __expf(-z1)))); }
        *yp = o;
    }
}
}

namespace mls {
using att::s16x4; using att::vtr; using att::cvtpk;
constexpr int QP = 272, VP = 320;
constexpr int L_Q = 0, L_K = 17408, L_KW = 34816, L_V = 55296, L_U = 75776, L_CJ = L_U + 256, L_IW = L_CJ + 256, L_FL = L_IW + 256, L_WK = L_FL + 256, L_QN = L_WK + 256,
              L_N = L_QN + 256  , L_SS = L_N + 1024  , L_SC = L_SS + 1024  , L_CW = L_SC + 256  , L_NG = L_CW + 5 * 1024  ;
__device__ __forceinline__ bf16x8 pack8(const f32x16& x, const int s2) { u32x4 w;
#pragma unroll
    for (int j = 0; j < 4; ++j) w[j] = cvtpk(x[8 * s2 + 2 * j], x[8 * s2 + 2 * j + 1]);
    return __builtin_bit_cast(bf16x8, w); }

__device__ __forceinline__ void unit(const Params& P, int l, int b, int h, LAS unsigned char* lds, const int wid) {
    const int tid = PHASE_TID(wid);
    const int lane = tid & 63, r32 = lane & 31, hh = lane >> 5, g16 = lane >> 4, i16 = lane & 15;
    const bf16_t* p = (const bf16_t*)(P.ws + WS_P); bf16_t* y = (bf16_t*)(P.ws + WS_XB); const float* gates = (const float*)(P.ws + WS_GATES);
    const int cgq = tid & 31, tq = tid >> 5, cisk = cgq >> 4, ccol = (cisk ? C_MLK : C_MLQ) + 128 * h + 8 * (cgq & 15);
    const float cscale = cisk ? 0.08838834764831845f : 1.0f;
    if (tid < 256) { const int cidx = ((tid >> 7) ? 512 : 0) + 128 * h + (tid & 127);
#pragma unroll
        for (int j = 0; j < 4; ++j) ((LAS float*)(lds + L_CW))[j * 256 + tid] = P.in[18][(l * 4 + j) * 1024 + cidx];
        ((LAS float*)(lds + L_CW))[4 * 256 + tid] = P.in[19][l * 1024 + cidx]; }
    if (tid < 128) ((LAS float*)(lds + L_NG))[tid] = P.in[22][l * 512 + 128 * h + tid];
    if (tid == 0) { LAS float* sc_ = (LAS float*)(lds + L_SC); sc_[2] = P.in[20][l * 4 + h]; sc_[3] = P.in[21][l * 4 + h]; sc_[4] = P.in[4][l * 4 + 1]; }
    const int vb = wid & 3, jb = wid >> 2, jl = 32 * jb + r32;
    f32x16 ct[4];
#pragma unroll
    for (int kb = 0; kb < 4; ++kb)
#pragma unroll
        for (int r = 0; r < 16; ++r) ct[kb][r] = 0.f;
    float m_prev = 0.f;
    if (tid < 256) ((LAS float*)(lds + L_N))[tid] = 0.f;
    __syncthreads();
    const int trow = (i16 >> 2), tcol = (16 * (g16 & 1) + 4 * (i16 & 3)) * 2;
    u32x4 cxr[7]; u32x4 vreg[2]; float g_ig, g_fx; u32x2 oo[4], zz[4];
#define MLS_LOAD(c_) do { const size_t tk_ = (size_t)b * TT + (size_t)(c_) * 64; \
        const bf16_t* src_ = p + (tk_ + 4 * tq) * NP + ccol; const bool hp_ = ((c_) > 0) || (tq > 0); \
        _Pragma("unroll") for (int i_ = 0; i_ < 7; ++i_) cxr[i_] = *(const u32x4*)(src_ + (long)((hp_ || i_ >= 3) ? (i_ - 3) : 0) * NP); \
        _Pragma("unroll") for (int i_ = 0; i_ < 2; ++i_) { const int cc_ = tid + 512 * i_; vreg[i_] = *(const u32x4*)(p + (tk_ + (cc_ >> 4)) * NP + C_MLV + 128 * h + (cc_ & 15) * 8); } \
        g_ig = gates[(tk_ + lane) * 8 + h]; g_fx = gates[(tk_ + lane) * 8 + 4 + h]; } while (0)
    MLS_LOAD(0);
#pragma unroll 1
    for (int c = 0; c < TT / 64; ++c) {
        const size_t tok0 = (size_t)b * TT + c * 64;
        LAS float* Nold = (LAS float*)(lds + L_N) + 128 * (c & 1); LAS float* Nnew = (LAS float*)(lds + L_N) + 128 * ((c + 1) & 1);
        if (wid == 0) {
            const float ig = g_ig + ((const LAS float*)(lds + L_SC))[2]; const float fx = g_fx + ((const LAS float*)(lds + L_SC))[3]; const float lf = -0.6931471805599453f * __builtin_amdgcn_logf(1.0f + __builtin_amdgcn_exp2f(-1.4426950408889634f * fx));
            const float bs = scan_sum64(lf);
            const float u = ig - bs; const float pm = scan_max64(u);
            const float mx = fmaxf(m_prev, pm), mj = bs + mx, cj = -mx;
            const float b_last = lane63(bs), pm_last = lane63(pm), m_new = b_last + fmaxf(m_prev, pm_last);
            ((LAS float*)(lds + L_U))[lane] = u; ((LAS float*)(lds + L_CJ))[lane] = cj; ((LAS float*)(lds + L_IW))[lane] = __expf(cj + m_prev);
            ((LAS float*)(lds + L_FL))[lane] = __expf(-mj); ((LAS float*)(lds + L_WK))[lane] = __expf(b_last + u - m_new);
            if (lane == 0) { ((LAS float*)(lds + L_SC))[0] = __expf(b_last + m_prev - m_new); ((LAS float*)(lds + L_SC))[1] = m_new; }
        }
#pragma unroll
        for (int i = 0; i < 2; ++i) { const int cc = tid + 512 * i; *(LAS u32x4*)(lds + L_V + (cc >> 4) * VP + (cc & 15) * 16) = vreg[i]; }
        {
            const float pz = ((c > 0) || (tq > 0)) ? 1.0f : 0.0f;
            const LAS float* cwt = (const LAS float*)(lds + L_CW) + 8 * cgq;
            float w0[8], w1[8], w2[8], w3[8], bb[8];
            wkv::ld8(w0, cwt); wkv::ld8(w1, cwt + 256); wkv::ld8(w2, cwt + 512); wkv::ld8(w3, cwt + 768); wkv::ld8(bb, cwt + 1024);
            float xa[8], xb_[8], xc[8], xd[8];
            wkv::unp8(xa, cxr[0]); wkv::unp8(xb_, cxr[1]); wkv::unp8(xc, cxr[2]);
#pragma unroll
            for (int j = 0; j < 8; ++j) { xa[j] *= pz; xb_[j] *= pz; xc[j] *= pz; }
            LAS unsigned char* dst = lds + (cisk ? L_K : L_Q) + (4 * tq) * QP + 16 * (cgq & 15);
#pragma unroll
            for (int i = 0; i < 4; ++i) {
                wkv::unp8(xd, cxr[3 + i]);
                u32x4 o;
#pragma unroll
                for (int j2 = 0; j2 < 4; ++j2) { float r2[2];
#pragma unroll
                    for (int e = 0; e < 2; ++e) { const int j = 2 * j2 + e; const float cv = bb[j] + xa[j] * w0[j] + xb_[j] * w1[j] + xc[j] * w2[j] + xd[j] * w3[j];
                        r2[e] = cv * __builtin_amdgcn_rcpf(1.0f + __expf(-cv)) * cscale; }
                    o[j2] = pk2(r2[0], r2[1]); }
                *(LAS u32x4*)(dst + i * QP) = o;
#pragma unroll
                for (int j = 0; j < 8; ++j) { xa[j] = xb_[j]; xb_[j] = xc[j]; xc[j] = xd[j]; }
            }
        }
        {
            const size_t tok = tok0 + jl; const bf16_t* orow = p + tok * NP + C_MLO + 128 * h; const bf16_t* zrow = p + tok * NP + C_Z + Y_ML + 128 * h;
#pragma unroll
            for (int g = 0; g < 4; ++g) { const int v = 32 * vb + 8 * g + 4 * hh; oo[g] = *(const u32x2*)(orow + v); zz[g] = *(const u32x2*)(zrow + v); }
        }
        LDS_BARRIER();
        m_prev = ((const LAS float*)(lds + L_SC))[1];
        {
            const int s_ = tid >> 3, k0 = (tid & 7) * 16; const float wk = ((const LAS float*)(lds + L_WK))[s_];
            float qn = 0.f;
#pragma unroll
            for (int q = 0; q < 2; ++q) { const u32x4 kv = *(const LAS u32x4*)(lds + L_K + s_ * QP + (k0 + 8 * q) * 2); u32x4 o;
#pragma unroll
                for (int j = 0; j < 4; ++j) o[j] = pk2(__uint_as_float(kv[j] << 16) * wk, __uint_as_float(kv[j] & 0xffff0000u) * wk);
                *(LAS u32x4*)(lds + L_KW + s_ * VP + (k0 + 8 * q) * 2) = o;
                const u32x4 qv = *(const LAS u32x4*)(lds + L_Q + s_ * QP + (k0 + 8 * q) * 2); const f32x4 n0 = *(const LAS f32x4*)(Nold + k0 + 8 * q), n1 = *(const LAS f32x4*)(Nold + k0 + 8 * q + 4);
                qn += __uint_as_float(qv[0] << 16) * n0[0] + __uint_as_float(qv[0] & 0xffff0000u) * n0[1] + __uint_as_float(qv[1] << 16) * n0[2] + __uint_as_float(qv[1] & 0xffff0000u) * n0[3]
                    + __uint_as_float(qv[2] << 16) * n1[0] + __uint_as_float(qv[2] & 0xffff0000u) * n1[1] + __uint_as_float(qv[3] << 16) * n1[2] + __uint_as_float(qv[3] & 0xffff0000u) * n1[3]; }
            qn = sum8(qn);
            if ((tid & 7) == 0) ((LAS float*)(lds + L_QN))[s_] = qn;
            { const int k = tid >> 2, sq_ = (tid & 3) * 16; float acc = 0.f;
#pragma unroll
              for (int s2 = 0; s2 < 16; ++s2) acc += ((const LAS float*)(lds + L_WK))[sq_ + s2] * bf2f(((const LAS bf16_t*)(lds + L_K + (sq_ + s2) * QP))[k]);
              acc = sum4(acc);
              if ((tid & 3) == 0) Nnew[k] = ((const LAS float*)(lds + L_SC))[0] * Nold[k] + acc; }
        }
        if (c + 1 < TT / 64) MLS_LOAD(c + 1);
        LDS_BARRIER();
        unsigned gf[8];
#pragma unroll
        for (int g = 0; g < 4; ++g) {
            const float o0 = blo(oo[g].x), o1 = bhi(oo[g].x), o2 = blo(oo[g].y), o3 = bhi(oo[g].y), z0 = blo(zz[g].x), z1 = bhi(zz[g].x), z2 = blo(zz[g].y), z3 = bhi(zz[g].y);
#define GF_(o_, z_) ((z_) * __builtin_amdgcn_rcpf((1.0f + __expf(-(o_))) * (1.0f + __expf(-(z_)))))
            gf[2 * g] = pk2(GF_(o0, z0), GF_(o1, z1)); gf[2 * g + 1] = pk2(GF_(o2, z2), GF_(o3, z3));
#undef GF_
        }
        f32x16 num; float dsum = 0.f;
#pragma unroll
        for (int r = 0; r < 16; ++r) num[r] = 0.f;
        const float cj = ((const LAS float*)(lds + L_CJ))[jl];
#pragma unroll
        for (int sb = 0; sb < 2; ++sb) {
            if (sb <= jb) {
                f32x16 s;
#pragma unroll
                for (int r = 0; r < 16; ++r) s[r] = 0.f;
                {
                    const LAS unsigned char* kp_ = lds + L_K + (32 * sb + r32) * QP + 16 * hh; const LAS unsigned char* qp_ = lds + L_Q + jl * QP + 16 * hh;
                    bf16x8 ak_[3], bq_[3];
#pragma unroll
                    for (int ks = 0; ks < 3; ++ks) { ak_[ks] = *(const LAS bf16x8*)(kp_ + 32 * ks); bq_[ks] = *(const LAS bf16x8*)(qp_ + 32 * ks); }
#pragma unroll
                    for (int ks = 0; ks < 8; ++ks) {
                        s = MFMA32(ak_[ks % 3], bq_[ks % 3], s);
                        if (ks + 3 < 8) { ak_[ks % 3] = *(const LAS bf16x8*)(kp_ + 32 * (ks + 3)); bq_[ks % 3] = *(const LAS bf16x8*)(qp_ + 32 * (ks + 3)); }
                    }
                }
                LAS unsigned char* vbase = lds + L_V + (trow + 4 * hh + 32 * sb) * VP + 64 * vb + tcol;
                const s16x4 lo0 = vtr(vbase), hi0 = vtr(vbase + 8 * VP), lo1 = vtr(vbase + 16 * VP), hi1 = vtr(vbase + 24 * VP);
#pragma unroll
                for (int g = 0; g < 4; ++g) { const f32x4 u4 = *(const LAS f32x4*)(lds + L_U + (32 * sb + 8 * g + 4 * hh) * 4);
#pragma unroll
                    for (int i = 0; i < 4; ++i) { const int srow = 32 * sb + 8 * g + 4 * hh + i; const float w = srow <= jl ? __expf(cj + u4[i]) : 0.f; s[4 * g + i] *= w; dsum += s[4 * g + i]; } }
                const bf16x8 pf0 = pack8(s, 0), pf1 = pack8(s, 1);
                num = MFMA32(__builtin_shufflevector(lo0, hi0, 0, 1, 2, 3, 4, 5, 6, 7), pf0, num);
                num = MFMA32(__builtin_shufflevector(lo1, hi1, 0, 1, 2, 3, 4, 5, 6, 7), pf1, num);
            }
        }
        dsum = xor32_sum(dsum);
        f32x16 it;
#pragma unroll
        for (int r = 0; r < 16; ++r) it[r] = 0.f;
        {
            const LAS unsigned char* qb_ = lds + L_Q + jl * QP + 8 * hh;
            bf16x8 qq_[3];
#pragma unroll
            for (int i = 0; i < 3; ++i) { const s16x4 lo = *(const LAS s16x4*)(qb_ + 32 * i), hi = *(const LAS s16x4*)(qb_ + 32 * i + 16); qq_[i] = __builtin_shufflevector(lo, hi, 0, 1, 2, 3, 4, 5, 6, 7); }
#pragma unroll
            for (int i = 0; i < 8; ++i) {
                it = MFMA32(pack8(ct[i >> 1], i & 1), qq_[i % 3], it);
                if (i + 3 < 8) { const s16x4 lo = *(const LAS s16x4*)(qb_ + 32 * (i + 3)), hi = *(const LAS s16x4*)(qb_ + 32 * (i + 3) + 16); qq_[i % 3] = __builtin_shufflevector(lo, hi, 0, 1, 2, 3, 4, 5, 6, 7); }
            }
        }
        const float iw = ((const LAS float*)(lds + L_IW))[jl], fl = ((const LAS float*)(lds + L_FL))[jl], qn = ((const LAS float*)(lds + L_QN))[jl];
        const float den = dsum + iw * qn; const float dd = 1.0f / fmaxf(fabsf(den), fl);
        float ss = 0.f;
#pragma unroll
        for (int r = 0; r < 16; ++r) { num[r] = (num[r] + iw * it[r]) * dd; ss += num[r] * num[r]; }
        ss = xor32_sum(ss);
        if (hh == 0) ((LAS float*)(lds + L_SS))[vb * 64 + jl] = ss;
        {
            const float a_old = ((const LAS float*)(lds + L_SC))[0];
            LAS unsigned char* ka0 = lds + L_KW + (trow + 8 * hh) * VP + tcol; LAS unsigned char* va0 = lds + L_V + (trow + 8 * hh) * VP + 64 * vb + tcol;
            bf16x8 vfr_[4], kfr_[2];
#pragma unroll
            for (int s4 = 0; s4 < 4; ++s4) { const s16x4 lo = vtr(va0 + 16 * s4 * VP), hi = vtr(va0 + (16 * s4 + 4) * VP); vfr_[s4] = __builtin_shufflevector(lo, hi, 0, 1, 2, 3, 4, 5, 6, 7); }
#pragma unroll
            for (int i = 0; i < 2; ++i) { const s16x4 lo = vtr(ka0 + 16 * (i & 3) * VP + 64 * (i >> 2)), hi = vtr(ka0 + (16 * (i & 3) + 4) * VP + 64 * (i >> 2)); kfr_[i] = __builtin_shufflevector(lo, hi, 0, 1, 2, 3, 4, 5, 6, 7); }
#pragma unroll
            for (int kb = 0; kb < 4; ++kb) {
#pragma unroll
                for (int r = 0; r < 16; ++r) ct[kb][r] *= a_old;
#pragma unroll
                for (int s4 = 0; s4 < 4; ++s4) { const int i = 4 * kb + s4;
                    ct[kb] = MFMA32(kfr_[i & 1], vfr_[s4], ct[kb]);
                    if (i + 2 < 16) { const int n = i + 2; const s16x4 lo = vtr(ka0 + 16 * (n & 3) * VP + 64 * (n >> 2)), hi = vtr(ka0 + (16 * (n & 3) + 4) * VP + 64 * (n >> 2)); kfr_[i & 1] = __builtin_shufflevector(lo, hi, 0, 1, 2, 3, 4, 5, 6, 7); }
                }
            }
        }
        LDS_BARRIER();
        {
            const LAS float* SS = (const LAS float*)(lds + L_SS);
            const float tot = SS[jl] + SS[64 + jl] + SS[128 + jl] + SS[192 + jl];
            const float rs = rsqrtf(tot * (1.0f / 128.f) + 1e-6f) * ((const LAS float*)(lds + L_SC))[4];
            const size_t tok = tok0 + jl;
            bf16_t* yrow = y + tok * DM + Y_ML + 128 * h; const LAS float* ng = (const LAS float*)(lds + L_NG);
#pragma unroll
            for (int g = 0; g < 4; ++g) { const int v = 32 * vb + 8 * g + 4 * hh; const f32x4 gg = *(const LAS f32x4*)(ng + v);
                const float gv[4] = {blo(gf[2 * g]), bhi(gf[2 * g]), blo(gf[2 * g + 1]), bhi(gf[2 * g + 1])};
                float res[4];
#pragma unroll
                for (int i = 0; i < 4; ++i) res[i] = rs * gg[i] * num[4 * g + i] * gv[i];
                u32x2 w; w.x = pk2(res[0], res[1]); w.y = pk2(res[2], res[3]); *(u32x2*)(yrow + v) = w; }
        }
    }
#undef MLS_LOAD
}
}

#define XB_TMO      128
#define XB_XCNT(j)  (256  + 64 * (j))
#define XB_XSUB(j)  (1280 + 64 * (j))
#define XB_XGEN(j)  (2304 + 64 * (j))
#define XB_TOP      3328
#define XB_TOPGEN   3392
#define XCD_BAR_WORDS 3456
#define XB_SPIN_CAP (1u << 22)
__device__ __forceinline__ unsigned xb_ld(unsigned* p)              { return __hip_atomic_load(p, __ATOMIC_RELAXED, __HIP_MEMORY_SCOPE_AGENT); }
__device__ __forceinline__ unsigned xb_add(unsigned* p, unsigned v) { return __hip_atomic_fetch_add(p, v, __ATOMIC_RELAXED, __HIP_MEMORY_SCOPE_AGENT); }
__device__ __forceinline__ unsigned xb_xcc_id() { return (unsigned)__builtin_amdgcn_s_getreg((3 << 11) | 20) & 0xFu; }
#define XB_SPIN(cond, bar) do { unsigned _sp = 0; while (cond) { __builtin_amdgcn_s_sleep(1); \
    if ((++_sp & 255u) == 0u) { if (xb_ld(&(bar)[XB_TMO])) break; if (_sp > XB_SPIN_CAP) { atomicAdd(&(bar)[XB_TMO], 1u); break; } } } } while (0)
__device__ __forceinline__ void xcd_barrier_complete(unsigned* bar, unsigned x, unsigned& nloc, unsigned& nx, const unsigned G) {
    unsigned sum, cnt, mine, sp = 0u;
    for (;;) {
        sum = 0u; cnt = 0u; mine = 0u;
#pragma unroll
        for (unsigned j = 0; j < 16; ++j) { const unsigned c = xb_ld(&bar[XB_XCNT(j)]); sum += c; cnt += (c > 0u) ? 1u : 0u; mine = (j == x) ? c : mine; }
        if (sum == G) break;
        __builtin_amdgcn_s_sleep(1);
        if ((++sp & 255u) == 0u) { if (xb_ld(&bar[XB_TMO])) break; if (sp > XB_SPIN_CAP) { atomicAdd(&bar[XB_TMO], 1u); break; } }
    }
    nloc = mine > 0u ? mine : 1u; nx = cnt > 0u ? cnt : 1u;
}
__device__ __forceinline__ void xcd_barrier(unsigned* bar, volatile LAS unsigned* st, const int wid, const unsigned nblocks) {
    asm volatile("s_waitcnt vmcnt(0)" ::: "memory");
    __syncthreads();
    if (wid == 0 && lane_id_opaque() == 0) {
        __builtin_amdgcn_s_waitcnt(0);
        const unsigned x = xb_xcc_id();
        unsigned nloc = st[0], nx = st[1];
        if (nloc == 0u) { xcd_barrier_complete(bar, x, nloc, nx, nblocks); st[0] = nloc; st[1] = nx; }
        const unsigned old = xb_add(&bar[XB_XSUB(x)], 1u);
        const unsigned gen = old / nloc;
        if (old + 1u == (gen + 1u) * nloc) {
            __builtin_amdgcn_fence(__ATOMIC_RELEASE, "agent");
            asm volatile("s_waitcnt vmcnt(0)" ::: "memory");
            const unsigned og = xb_add(&bar[XB_TOP], 1u);
            const unsigned tg = og / nx;
            if (og + 1u == (tg + 1u) * nx) xb_add(&bar[XB_TOPGEN], 1u);
            else XB_SPIN(xb_ld(&bar[XB_TOPGEN]) == tg, bar);
            __builtin_amdgcn_fence(__ATOMIC_ACQUIRE, "agent");
            xb_add(&bar[XB_XGEN(x)], 1u);
            asm volatile("s_waitcnt vmcnt(0)" ::: "memory");
        } else {
            XB_SPIN(xb_ld(&bar[XB_XGEN(x)]) == gen, bar);
            __builtin_amdgcn_fence(__ATOMIC_ACQUIRE, "agent");
            asm volatile("s_waitcnt vmcnt(0)" ::: "memory");
        }
    }
    __syncthreads();
}

__device__ __forceinline__ void flag_set(unsigned* f, const int wid) { if (wid == 0 && lane_id_opaque() == 0) __hip_atomic_store(f, 1u, __ATOMIC_RELAXED, __HIP_MEMORY_SCOPE_AGENT); }
__device__ __forceinline__ void flag_wait(unsigned* f, const int wid) {
    if (wid == 0 && lane_id_opaque() == 0) {
        unsigned sp = 0; while (__hip_atomic_load(f, __ATOMIC_RELAXED, __HIP_MEMORY_SCOPE_AGENT) == 0u && ++sp < (1u << 24)) __builtin_amdgcn_s_sleep(8);
        __builtin_amdgcn_fence(__ATOMIC_ACQUIRE, "agent");
        asm volatile("s_waitcnt vmcnt(0)" ::: "memory");
    }
    __syncthreads();
}

__global__ void __launch_bounds__(512, 2) k_mega(Params P) {
    extern __shared__ __attribute__((aligned(16))) unsigned char dynlds[];
    LAS unsigned char* lds = (LAS unsigned char*)dynlds;
    cg::grid_group grid = cg::this_grid();
    unsigned char* ws = P.ws;
    const int wid0 = __builtin_amdgcn_readfirstlane((int)(threadIdx.x >> 6));
    unsigned* xbar = (unsigned*)(ws + WS_CTL) + 16384;
    unsigned* xbar2 = (unsigned*)(ws + WS_CTL) + 16384 + 4096;
    unsigned* flags = (unsigned*)(ws + WS_CTL) + 64 * 48;
    volatile LAS unsigned* xst = (volatile LAS unsigned*)(lds + 147456 - 16);
    constexpr int NSCAN = 144;
    if (threadIdx.x < 4) xst[threadIdx.x] = 0u;
    __syncthreads();
#define GRID_BAR() do { int w_ = wid0; OPAQUE_S(w_); xcd_barrier(xbar, xst, w_, gridDim.x); } while (0)
#define GROUP_BAR() do { int w_ = wid0; OPAQUE_S(w_); xcd_barrier(xbar2, xst + 2, w_, gridDim.x - NSCAN); } while (0)
#define PHASE_IDS int wid = wid0, bid = (int)blockIdx.x, G = (int)gridDim.x; OPAQUE_S(wid); OPAQUE_S(bid); OPAQUE_S(G)
    for (unsigned i = blockIdx.x * 512u + threadIdx.x; i < 32768u; i += gridDim.x * 512u) ((unsigned*)(ws + WS_CTL))[i] = 0u;
    { PHASE_IDS; (void)bid; (void)G; prologue_phase(P, lds, wid); }
    grid.sync();
    if (threadIdx.x == 0) { (void)xb_add(&xbar[XB_XCNT(xb_xcc_id())], 1u); if ((int)blockIdx.x >= NSCAN) (void)xb_add(&xbar2[XB_XCNT(xb_xcc_id())], 1u); }
#pragma unroll 1
    for (int l = 0; l < 2; ++l) {
        { PHASE_IDS; (void)bid; (void)G; p1_phase(P, l, lds, wid); }
        GRID_BAR();
        {
            PHASE_IDS;
            pg8::Gemm g{(const bf16_t*)(ws + WS_XB), (const bf16_t*)(ws + WS_WIN(l)), NTOK, NP, DM, DM};
            pg8::EpiRowScaleBf16 E{(bf16_t*)(ws + WS_P), (const float*)(ws + WS_RSTD), NP, 0};
            pg8::StaticOrder S; S.init(NTOK, NP, G, bid);
            pg8::gemm_phase<pg8::EpiRowScaleBf16, pg8::StaticOrder, true>(lds, g, S, E, wid);
        }
        GRID_BAR();
        { int bsel = (int)blockIdx.x; OPAQUE_S(bsel);
          if (bsel < NSCAN) {
              { PHASE_IDS; (void)G;
                if (bid < 128) { if (l == 1) flag_wait(flags + 64 * 0, wid); wkv::unit(P, l, bid >> 5, (bid >> 2) & 7, bid & 3, lds, wid); }
                else mls::unit(P, l, (bid - 128) >> 2, (bid - 128) & 3, lds, wid); }
              { int w_ = wid0; OPAQUE_S(w_); __syncthreads(); flag_wait(flags + 64 * (1 + l), w_); }
          } else {
              if (l == 1) { { PHASE_IDS; vl_phase(P, wid, bid - NSCAN, G - NSCAN); } GROUP_BAR(); { int w_ = wid0, b_ = (int)blockIdx.x; OPAQUE_S(w_); OPAQUE_S(b_); if (b_ == NSCAN) flag_set(flags + 64 * 0, w_); } }
              { PHASE_IDS;
                pg8::Gemm g{(const bf16_t*)(ws + WS_P) + C_QLAT, (const bf16_t*)(ws + WS_WQ(l)), NTOK, 768, 384, NP};
                pg8::EpiRowScaleBf16 E{(bf16_t*)(ws + WS_QRAW), nullptr, 768, 0};
                pg8::StaticOrder S; S.init(NTOK, 768, G - NSCAN, bid - NSCAN);
                pg8::gemm_phase<pg8::EpiRowScaleBf16, pg8::StaticOrder, true>(lds, g, S, E, wid); }
              { PHASE_IDS;
                pg8::Gemm g{(const bf16_t*)(ws + WS_P) + C_KVLAT, (const bf16_t*)(ws + WS_WKV(l)), NTOK, 1024, 256, NP};
                pg8::EpiRowScaleBf16 E{(bf16_t*)(ws + WS_KVRAW), nullptr, 1024, 0};
                pg8::StaticOrder S; S.init(NTOK, 1024, G - NSCAN, bid - NSCAN);
                pg8::gemm_phase<pg8::EpiRowScaleBf16, pg8::StaticOrder, true>(lds, g, S, E, wid); }
              { PHASE_IDS; da_prep_phase(P, l, wid, bid - NSCAN, G - NSCAN); }
              GROUP_BAR();
              { PHASE_IDS; mla_prep_phase(P, l, lds, wid, bid - NSCAN, G - NSCAN); }
              GROUP_BAR();
              { int w_ = wid0, b_ = (int)blockIdx.x; OPAQUE_S(w_); OPAQUE_S(b_); if (b_ == NSCAN) flag_set(flags + 64 * (1 + l), w_); }
          }
        }
        __syncthreads();
        { PHASE_IDS; (void)bid; (void)G;
          const int ln_ = lane_id_opaque();
          const float dq_ = lane63(scan_max64(fabsf(P.in[29][l * 64 + ln_]))), dk_ = lane63(scan_max64(fabsf(P.in[30][l * 64 + ln_])));
          const float mq_ = lane63(scan_max64(fmaxf(fabsf(P.in[27][l * 192 + ln_]), fmaxf(fabsf(P.in[27][l * 192 + 64 + ln_]), fabsf(P.in[27][l * 192 + 128 + ln_])))));
          const float mk_ = lane63(scan_max64(fmaxf(fabsf(P.in[28][l * 192 + ln_]), fmaxf(fabsf(P.in[28][l * 192 + 64 + ln_]), fabsf(P.in[28][l * 192 + 128 + ln_])))));
          if (dq_ * dk_ <= 5.19f && mq_ * mk_ <= 3.0f) att::attn_phase<true>(P, l, lds, (unsigned*)(ws + WS_CTL) + 64 * (16 + 2 * l), wid);
          else att::attn_phase<false>(P, l, lds, (unsigned*)(ws + WS_CTL) + 64 * (16 + 2 * l), wid); }
        GRID_BAR();
        { PHASE_IDS; (void)bid; (void)G; wkv::post_phase(P, l, wid); }
        GRID_BAR();
        {
            PHASE_IDS;
            pg8::Gemm g{(const bf16_t*)(ws + WS_XB), (const bf16_t*)(ws + WS_WOUT(l)), NTOK, DM, DM, DM};
            pg8::EpiResidual E{l == 0 ? P.in[0] : P.out, P.out, DM, 0};
            pg8::StaticOrder S; S.init(NTOK, DM, G, bid);
            pg8::gemm_phase<pg8::EpiResidual, pg8::StaticOrder, true>(lds, g, S, E, wid);
        }
        if (l == 0) GRID_BAR();
    }
#undef PHASE_IDS
#undef GRID_BAR
#undef GROUP_BAR
}

extern "C" void kernel_launch(void* const* d_in, const int* in_sizes, int n_in, void* d_out, int out_size, void* d_ws, size_t ws_size, hipStream_t stream) {
    if (n_in != 36 || out_size != NTOK * DM || ws_size < WS_END) { fprintf(stderr, "kernel_launch: unexpected shapes (n_in %d out %d ws %zu)\n", n_in, out_size, ws_size); return; }
    Params P{};
    for (int i = 0; i < 36; ++i) P.in[i] = (const float*)d_in[i];
    P.out = (float*)d_out; P.ws = (unsigned char*)d_ws;
    constexpr size_t kDynLds = 147456;
    static int coop_grid = 0;
    if (!coop_grid) {
        int dev = 0, cus = 0, per_cu = 0;
        (void)hipGetDevice(&dev); (void)hipDeviceGetAttribute(&cus, hipDeviceAttributeMultiprocessorCount, dev);
        (void)hipFuncSetAttribute((const void*)k_mega, hipFuncAttributeMaxDynamicSharedMemorySize, (int)kDynLds);
        (void)hipOccupancyMaxActiveBlocksPerMultiprocessor(&per_cu, (const void*)k_mega, 512, kDynLds);
        coop_grid = cus * per_cu;
        if (coop_grid <= 0) { fprintf(stderr, "kernel_launch: occupancy query gave %d x %d\n", cus, per_cu); coop_grid = 0; return; }
    }
    void* args[] = {&P};
    hipError_t e = hipLaunchCooperativeKernel((const void*)k_mega, dim3(coop_grid), dim3(512), args, kDynLds, stream);
    if (e != hipSuccess) fprintf(stderr, "cooperative launch failed: %s (grid %d)\n", hipGetErrorString(e), coop_grid);
}
```
